# Optimizing an MI355X kernel written in HIP

```python
import math
import jax, jax.numpy as jnp
from jax import lax
import numpy as np

D_MODEL = 1024
BATCH = 4
SEQ = 8192
DEPTH = 2

D_FF = 2816
ALPHA = (2 * DEPTH) ** 0.25
BETA = (8 * DEPTH) ** -0.25
LN_EPS = 1e-5
NEG = -1e30

A_HEADS = 8
A_DH = 64
A_WIDTH = A_HEADS * A_DH
MOBA_BLOCK = 256
MOBA_TOPK = 3
MOBA_QCHUNK = 64
ROPE_THETA = 10000.0

B_GROUPS = 8
B_DG = 64
B_WIDTH = B_GROUPS * B_DG
SGU_CHUNK = 128
AB_IN = 3 * A_WIDTH + 2 * B_WIDTH
AB_MIX = A_WIDTH + B_WIDTH

C_HEADS = 4
C_DQK = 128
C_DV = 256
C_QK_WIDTH = C_HEADS * C_DQK
C_WIDTH = C_HEADS * C_DV
C_IN = 2 * C_QK_WIDTH + 2 * C_WIDTH + 2 * C_HEADS
MLSTM_CHUNK = 64
CONV_W = 4

kernel_name = "hybrid_moba_sgu_mlstm_macaron_deepnorm"


def layer_norm(x, g, b):
    xf = x.astype(jnp.float32)
    mu = jnp.mean(xf, axis=-1, keepdims=True)
    var = jnp.mean(jnp.square(xf - mu), axis=-1, keepdims=True)
    y = (xf - mu) * lax.rsqrt(var + LN_EPS) * g.astype(jnp.float32) + b.astype(jnp.float32)
    return y.astype(x.dtype)


def swiglu(x, w_gu, w_down):
    g, u = jnp.split(x @ w_gu, 2, axis=-1)
    return (jax.nn.silu(g) * u) @ w_down


def rotary(x, pos):
    half = x.shape[-1] // 2
    inv = ROPE_THETA ** (-jnp.arange(half, dtype=jnp.float32) / half)
    ang = pos.astype(jnp.float32)[:, None] * inv[None, :]
    cos, sin = jnp.cos(ang), jnp.sin(ang)
    xf = x.astype(jnp.float32)
    x1, x2 = xf[..., :half], xf[..., half:]
    return jnp.concatenate([x1 * cos - x2 * sin, x2 * cos + x1 * sin], axis=-1).astype(x.dtype)


def moba_attention(q, k, v):
    Bn, H, S, dh = q.shape
    nb = -(-S // MOBA_BLOCK)
    pad = nb * MOBA_BLOCK - S
    kb = jnp.pad(k, ((0, 0), (0, 0), (0, pad), (0, 0))).reshape(Bn, H, nb, MOBA_BLOCK, dh)
    vb = jnp.pad(v, ((0, 0), (0, 0), (0, pad), (0, 0))).reshape(Bn, H, nb, MOBA_BLOCK, dh)
    k_mean = jnp.mean(kb.astype(jnp.float32), axis=3).astype(q.dtype)
    pos = jnp.arange(S)
    q_blk = pos // MOBA_BLOCK
    gate = jnp.einsum('bhsd,bhnd->bhsn', q, k_mean).astype(jnp.float32)
    past = jnp.arange(nb)[None, :] < q_blk[:, None]
    gate = jnp.where(past, gate, NEG)
    k_sel = min(MOBA_TOPK, nb)
    _, g_idx = lax.top_k(gate, k_sel)
    g_valid = g_idx < q_blk[None, None, :, None]
    scale = dh ** -0.5
    bi = jnp.arange(Bn)[:, None, None, None]
    hi = jnp.arange(H)[None, :, None, None]

    def step(c):
        start = c * MOBA_QCHUNK
        qc = lax.dynamic_slice_in_dim(q, start, MOBA_QCHUNK, axis=2)
        idx = lax.dynamic_slice_in_dim(g_idx, start, MOBA_QCHUNK, axis=2)
        val = lax.dynamic_slice_in_dim(g_valid, start, MOBA_QCHUNK, axis=2)
        blk = start // MOBA_BLOCK
        k_own = lax.dynamic_index_in_dim(kb, blk, axis=2, keepdims=False)
        v_own = lax.dynamic_index_in_dim(vb, blk, axis=2, keepdims=False)
        k_g = kb[bi, hi, idx]
        v_g = vb[bi, hi, idx]
        q_pos = start + jnp.arange(MOBA_QCHUNK)
        k_pos = blk * MOBA_BLOCK + jnp.arange(MOBA_BLOCK)
        s_own = jnp.einsum('bhqd,bhkd->bhqk', qc, k_own).astype(jnp.float32) * scale
        s_own = jnp.where(k_pos[None, :] <= q_pos[:, None], s_own, NEG)
        s_g = jnp.einsum('bhqd,bhqnkd->bhqnk', qc, k_g).astype(jnp.float32) * scale
        s_g = jnp.where(val[..., None], s_g, NEG)
        s = jnp.concatenate([s_own, s_g.reshape(Bn, H, MOBA_QCHUNK, k_sel * MOBA_BLOCK)], axis=-1)
        p = jax.nn.softmax(s, axis=-1).astype(v.dtype)
        p_own = p[..., :MOBA_BLOCK]
        p_g = p[..., MOBA_BLOCK:].reshape(Bn, H, MOBA_QCHUNK, k_sel, MOBA_BLOCK)
        return (jnp.einsum('bhqk,bhkd->bhqd', p_own, v_own)
                + jnp.einsum('bhqnk,bhqnkd->bhqd', p_g, v_g))

    outs = lax.map(step, jnp.arange(S // MOBA_QCHUNK))
    return jnp.moveaxis(outs, 0, 2).reshape(Bn, H, S, dh)


def spatial_gating(u, vg, ln_g, ln_b, w_s, b_s):
    Bn, S, _ = u.shape
    vg = layer_norm(vg, ln_g, ln_b)
    nc = S // SGU_CHUNK
    vr = vg.reshape(Bn, nc, SGU_CHUNK, B_GROUPS, B_DG)
    causal = jnp.tril(jnp.ones((SGU_CHUNK, SGU_CHUNK), dtype=bool))
    w = jnp.where(causal, w_s, jnp.zeros_like(w_s))
    mixed = jnp.einsum('gts,bcsgd->bctgd', w, vr) + b_s.T[None, None, :, :, None]
    return u * mixed.reshape(Bn, S, B_WIDTH)


def mixer_ab(x, w_in, sgu_ln_g, sgu_ln_b, sgu_w, sgu_b, w_out):
    Bn, S, _ = x.shape
    proj = x @ w_in
    qa, ka, va, ub, vb = jnp.split(
        proj, [A_WIDTH, 2 * A_WIDTH, 3 * A_WIDTH, 3 * A_WIDTH + B_WIDTH], axis=-1)
    heads = lambda t: t.reshape(Bn, S, A_HEADS, A_DH).transpose(0, 2, 1, 3)
    pos = jnp.arange(S)
    a = moba_attention(rotary(heads(qa), pos), rotary(heads(ka), pos), heads(va))
    a = a.transpose(0, 2, 1, 3).reshape(Bn, S, A_WIDTH)
    b = spatial_gating(jax.nn.gelu(ub), jax.nn.gelu(vb), sgu_ln_g, sgu_ln_b, sgu_w, sgu_b)
    return jnp.concatenate([a, b], axis=-1) @ w_out


def causal_depthwise_conv(x, w, b):
    K, C = w.shape
    y = lax.conv_general_dilated(x, w[:, None, :], window_strides=(1,), padding=[(K - 1, 0)],
                                 dimension_numbers=('NWC', 'WIO', 'NWC'), feature_group_count=C)
    return y + b


def mlstm_chunkwise(q, k, v, i_pre, f_pre):
    Bn, H, S, dk = q.shape
    dv = v.shape[-1]
    L = MLSTM_CHUNK
    nc = S // L
    f32 = jnp.float32
    qc = q.astype(f32).reshape(Bn, H, nc, L, dk)
    kc = (k.astype(f32) * dk ** -0.5).reshape(Bn, H, nc, L, dk)
    vc = v.astype(f32).reshape(Bn, H, nc, L, dv)
    ic = i_pre.reshape(Bn, H, nc, L)
    b = jnp.cumsum(jax.nn.log_sigmoid(f_pre).reshape(Bn, H, nc, L), axis=-1)
    b_end = b[..., -1]
    a = b_end[..., None] - b + ic
    a_max = jnp.max(a, axis=-1)
    w_end = jnp.exp(a - a_max[..., None])
    kv = jnp.einsum('bhcsk,bhcsv,bhcs->bhckv', kc, vc, w_end)
    ks = jnp.einsum('bhcsk,bhcs->bhck', kc, w_end)

    def scan_fn(carry, inp):
        C, n, m = carry
        kv_c, ks_c, be_c, am_c = inp
        m_new = jnp.maximum(be_c + m, am_c)
        decay = jnp.exp(be_c + m - m_new)
        inject = jnp.exp(am_c - m_new)
        C_new = decay[..., None, None] * C + inject[..., None, None] * kv_c
        n_new = decay[..., None] * n + inject[..., None] * ks_c
        return (C_new, n_new, m_new), (C, n, m)

    init = (jnp.zeros((Bn, H, dk, dv), f32), jnp.zeros((Bn, H, dk), f32), jnp.zeros((Bn, H), f32))
    xs = (jnp.moveaxis(kv, 2, 0), jnp.moveaxis(ks, 2, 0), jnp.moveaxis(b_end, 2, 0), jnp.moveaxis(a_max, 2, 0))
    _, (C_in, n_in, m_in) = lax.scan(scan_fn, init, xs)
    C_in = jnp.moveaxis(C_in, 0, 2)
    n_in = jnp.moveaxis(n_in, 0, 2)
    m_in = jnp.moveaxis(m_in, 0, 2)

    causal = jnp.tril(jnp.ones((L, L), dtype=bool))
    D = b[..., :, None] - b[..., None, :] + ic[..., None, :]
    D = jnp.where(causal, D, -jnp.inf)
    g = b + m_in[..., None]
    m_t = jnp.maximum(g, jnp.max(D, axis=-1))
    P = jnp.exp(D - m_t[..., None])
    sqk = jnp.einsum('bhctk,bhcsk->bhcts', qc, kc) * P
    inter = jnp.exp(g - m_t)
    num = (jnp.einsum('bhcts,bhcsv->bhctv', sqk, vc)
           + inter[..., None] * jnp.einsum('bhctk,bhckv->bhctv', qc, C_in))
    den = jnp.sum(sqk, axis=-1) + inter * jnp.einsum('bhctk,bhck->bhct', qc, n_in)
    h = num / jnp.maximum(jnp.abs(den), jnp.exp(-m_t))[..., None]
    return h.reshape(Bn, H, S, dv)


def mixer_c(x, w_in, conv_w, conv_b, b_i, b_f, head_g, w_out):
    Bn, S, _ = x.shape
    proj = x @ w_in
    qk, v, o_pre, if_pre = jnp.split(
        proj, [2 * C_QK_WIDTH, 2 * C_QK_WIDTH + C_WIDTH, 2 * C_QK_WIDTH + 2 * C_WIDTH], axis=-1)
    qk = jax.nn.silu(causal_depthwise_conv(qk, conv_w, conv_b))
    q, k = jnp.split(qk, 2, axis=-1)
    q = q.reshape(Bn, S, C_HEADS, C_DQK).transpose(0, 2, 1, 3)
    k = k.reshape(Bn, S, C_HEADS, C_DQK).transpose(0, 2, 1, 3)
    v = v.reshape(Bn, S, C_HEADS, C_DV).transpose(0, 2, 1, 3)
    if_f = if_pre.astype(jnp.float32)
    i_pre = (if_f[..., :C_HEADS] + b_i.astype(jnp.float32)).transpose(0, 2, 1)
    f_pre = (if_f[..., C_HEADS:] + b_f.astype(jnp.float32)).transpose(0, 2, 1)
    h = mlstm_chunkwise(q, k, v, i_pre, f_pre)
    mu = jnp.mean(h, axis=-1, keepdims=True)
    var = jnp.mean(jnp.square(h - mu), axis=-1, keepdims=True)
    h = (h - mu) * lax.rsqrt(var + LN_EPS) * head_g.astype(jnp.float32).reshape(C_HEADS, 1, C_DV)
    h = h.transpose(0, 2, 1, 3).reshape(Bn, S, C_WIDTH).astype(x.dtype)
    return (jax.nn.sigmoid(o_pre) * h) @ w_out


def setup_inputs(seed: int = 0) -> dict:
    key = jax.random.key(seed)
    ks = jax.random.split(key, 24)
    n_even = (DEPTH + 1) // 2
    n_odd = DEPTH // 2
    nrm = lambda kk, shape, s: s * jax.random.normal(kk, shape, jnp.float32)
    x = nrm(ks[0], (BATCH, SEQ, D_MODEL), 1.0)
    ln_g = 1.0 + nrm(ks[1], (DEPTH, 3, D_MODEL), 0.02)
    ln_b = nrm(ks[2], (DEPTH, 3, D_MODEL), 0.02)
    ffn_w_gu = nrm(ks[3], (DEPTH, 2, D_MODEL, 2 * D_FF), D_MODEL ** -0.5)
    ffn_w_down = nrm(ks[4], (DEPTH, 2, D_FF, D_MODEL), BETA * D_FF ** -0.5)
    ab_cols = jnp.concatenate([jnp.ones((2 * A_WIDTH,), jnp.float32),
                               jnp.full((A_WIDTH,), BETA, jnp.float32),
                               jnp.ones((2 * B_WIDTH,), jnp.float32)])
    ab_w_in = nrm(ks[5], (n_even, D_MODEL, AB_IN), D_MODEL ** -0.5) * ab_cols
    sgu_ln_g = 1.0 + nrm(ks[6], (n_even, B_WIDTH), 0.02)
    sgu_ln_b = nrm(ks[7], (n_even, B_WIDTH), 0.02)
    sgu_w = nrm(ks[8], (n_even, B_GROUPS, SGU_CHUNK, SGU_CHUNK), SGU_CHUNK ** -0.5)
    sgu_b = 1.0 + nrm(ks[9], (n_even, B_GROUPS, SGU_CHUNK), 0.02)
    ab_w_out = nrm(ks[10], (n_even, AB_MIX, D_MODEL), BETA * AB_MIX ** -0.5)
    c_cols = jnp.concatenate([jnp.ones((2 * C_QK_WIDTH,), jnp.float32),
                              jnp.full((C_WIDTH,), BETA, jnp.float32),
                              jnp.ones((C_WIDTH + 2 * C_HEADS,), jnp.float32)])
    c_w_in = nrm(ks[11], (n_odd, D_MODEL, C_IN), D_MODEL ** -0.5) * c_cols
    c_conv_w = nrm(ks[12], (n_odd, CONV_W, 2 * C_QK_WIDTH), CONV_W ** -0.5)
    c_conv_b = nrm(ks[13], (n_odd, 2 * C_QK_WIDTH), 0.02)
    c_b_i = nrm(ks[14], (n_odd, C_HEADS), 0.1)
    c_b_f = jnp.linspace(3.0, 6.0, C_HEADS, dtype=jnp.float32)[None, :] + nrm(ks[15], (n_odd, C_HEADS), 0.1)
    c_head_g = 1.0 + nrm(ks[16], (n_odd, C_WIDTH), 0.02)
    c_w_out = nrm(ks[17], (n_odd, C_WIDTH, D_MODEL), BETA * C_WIDTH ** -0.5)
    return {"x": x, "ln_g": ln_g, "ln_b": ln_b, "ffn_w_gu": ffn_w_gu, "ffn_w_down": ffn_w_down,
            "ab_w_in": ab_w_in, "sgu_ln_g": sgu_ln_g, "sgu_ln_b": sgu_ln_b, "sgu_w": sgu_w,
            "sgu_b": sgu_b, "ab_w_out": ab_w_out, "c_w_in": c_w_in, "c_conv_w": c_conv_w,
            "c_conv_b": c_conv_b, "c_b_i": c_b_i, "c_b_f": c_b_f, "c_head_g": c_head_g,
            "c_w_out": c_w_out}


def reference(x, ln_g, ln_b, ffn_w_gu, ffn_w_down, ab_w_in, sgu_ln_g, sgu_ln_b, sgu_w, sgu_b,
              ab_w_out, c_w_in, c_conv_w, c_conv_b, c_b_i, c_b_f, c_head_g, c_w_out):
    for l in range(DEPTH):
        x = layer_norm(ALPHA * x + 0.5 * swiglu(x, ffn_w_gu[l, 0], ffn_w_down[l, 0]), ln_g[l, 0], ln_b[l, 0])
        j = l // 2
        if l % 2 == 0:
            y = mixer_ab(x, ab_w_in[j], sgu_ln_g[j], sgu_ln_b[j], sgu_w[j], sgu_b[j], ab_w_out[j])
        else:
            y = mixer_c(x, c_w_in[j], c_conv_w[j], c_conv_b[j], c_b_i[j], c_b_f[j], c_head_g[j], c_w_out[j])
        x = layer_norm(ALPHA * x + y, ln_g[l, 1], ln_b[l, 1])
        x = layer_norm(ALPHA * x + 0.5 * swiglu(x, ffn_w_gu[l, 1], ffn_w_down[l, 1]), ln_g[l, 2], ln_b[l, 2])
    return x
```

```cpp
#include <hip/hip_runtime.h>
#include <hip/hip_cooperative_groups.h>
#include <hip/hip_bf16.h>
#include <cstdio>
#include <cstdint>
#include <cmath>
namespace cg = cooperative_groups;
#ifndef MK_MULTI
#define MK_MULTI 0
#endif
#define MK_NPHASES 64
namespace pg8 {
#define PG8_LAS __attribute__((address_space(3)))
typedef unsigned short bf16_t;
typedef short bf16x8 __attribute__((ext_vector_type(8)));
typedef float f32x4 __attribute__((ext_vector_type(4)));
typedef unsigned u32x4 __attribute__((ext_vector_type(4)));
constexpr int BM = 256, BK = 64, HALF = 128, HTB = HALF * BK * 2  , STAGE_BYTES = 8 * HTB, NXCD = 8, WGM = 8;

__host__ __device__ __forceinline__ int lds_byte(int r, int c) { const int st = (r >> 4) * 2 + (c >> 5), rr = r & 15, cc = c & 31, ob = rr * 64 + cc * 2; return st * 1024 + (ob ^ (((ob >> 9) & 1) << 5)); }
__host__ __device__ __forceinline__ void stage_rc(int b, int& R, int& C) { const int st = b / 1024, sb = b % 1024, swz = sb ^ (((sb >> 9) & 1) << 5); R = (st >> 1) * 16 + swz / 64; C = (st & 1) * 32 + (swz % 64) / 2; }
__host__ __device__ __forceinline__ int perm32(int rho) { const int n = rho >> 4, i = rho & 15; return 8 * (i >> 2) + 4 * n + (i & 3); }

struct Unit { int pm, pn; };
struct Gemm { const bf16_t* A; const bf16_t* Bt; int M, N, K, lda; };

struct StaticOrder {
    int nM, nN, nwg, G, c;
    __host__ __device__ void init(int M, int N, int G_, int c_) { nM = M / BM; nN = N / BM; nwg = nM * nN; G = G_; c = c_; }
    __host__ __device__ bool next(int i, Unit& u) const {
        const long L = (long)i * G + c; if (L >= nwg) return false;
        int wgid = (int)L; { const int q = nwg / NXCD, r = nwg % NXCD, xcd = wgid % NXCD, off = wgid / NXCD; wgid = (xcd < r ? xcd * (q + 1) : r * (q + 1) + (xcd - r) * q) + off; }
        const int nig = WGM * nN, gid = wgid / nig, fm = gid * WGM, gsz = (nM - fm) < WGM ? (nM - fm) : WGM;
        u.pm = fm + ((wgid % nig) % gsz); u.pn = (wgid % nig) / gsz; return true;
    }
    __device__ __forceinline__ void a_ready(const Unit&) const {}
    __device__ __forceinline__ void done(const Unit&) const {}
};

__device__ __forceinline__ unsigned cvt_pk_bf16(float lo, float hi) { unsigned r; asm volatile("v_cvt_pk_bf16_f32 %0, %1, %2" : "=v"(r) : "v"(lo), "v"(hi)); return r; }
typedef float f32x2 __attribute__((ext_vector_type(2)));
__device__ __forceinline__ float fast_sigmoid(float x) { return __builtin_amdgcn_rcpf(1.0f + __expf(-x)); }
__device__ __forceinline__ float gelu_tanh(float x) {
    const float u = 1.5957691216057308f * (x + 0.044715f * x * x * x);
    return x * fast_sigmoid(u);
}
struct EpiSwiGLU {
    static constexpr bool PERM = true, AFTER_DRAIN = false;
    bf16_t* H; int ldh;
    __device__ __forceinline__ void operator()(const f32x4 (&acc)[2][2][4][2], const Unit& u, int wr, int wc, int fr, int fq) const {
        const int row0 = u.pm * BM + wr * 64 + fr, col0 = u.pn * HALF + wc * 32 + 8 * fq;
#pragma unroll
        for (int ai = 0; ai < 2; ++ai)
#pragma unroll
            for (int m = 0; m < 4; ++m) {
                bf16_t* rowp = H + (size_t)(row0 + ai * HALF + m * 16) * ldh + col0;
                float h[8];
#pragma unroll
                for (int n = 0; n < 2; ++n)
#pragma unroll
                    for (int e = 0; e < 4; ++e) { const float g = acc[ai][0][m][n][e], uu = acc[ai][1][m][n][e]; h[4 * n + e] = g * fast_sigmoid(g) * uu; }
                u32x4 w; w.x = cvt_pk_bf16(h[0], h[1]); w.y = cvt_pk_bf16(h[2], h[3]); w.z = cvt_pk_bf16(h[4], h[5]); w.w = cvt_pk_bf16(h[6], h[7]);
                *(u32x4*)rowp = w;
            }
    }
};
struct EpiF32 {
    static constexpr bool PERM = false, AFTER_DRAIN = false;
    float* Y; int ldc;
    __device__ __forceinline__ void operator()(const f32x4 (&acc)[2][2][4][2], const Unit& u, int wr, int wc, int fr, int fq) const {
        const int row0 = u.pm * BM + wr * 64 + fr, col0 = u.pn * BM + wc * 32 + 4 * fq;
#pragma unroll
        for (int ai = 0; ai < 2; ++ai)
#pragma unroll
            for (int m = 0; m < 4; ++m) {
                float* rowp = Y + (size_t)(row0 + ai * HALF + m * 16) * ldc + col0;
#pragma unroll
                for (int bj = 0; bj < 2; ++bj)
#pragma unroll
                    for (int n = 0; n < 2; ++n) *(f32x4*)(rowp + bj * HALF + n * 16) = acc[ai][bj][m][n];
            }
    }
};
struct EpiBf16Plain {
    static constexpr bool PERM = true, AFTER_DRAIN = false;
    bf16_t* O; int ldc;
    __device__ __forceinline__ void operator()(const f32x4 (&acc)[2][2][4][2], const Unit& u, int wr, int wc, int fr, int fq) const {
        const int row0 = u.pm * BM + wr * 64 + fr, col0 = u.pn * BM + wc * 32 + 8 * fq;
#pragma unroll
        for (int ai = 0; ai < 2; ++ai)
#pragma unroll
            for (int m = 0; m < 4; ++m) {
                bf16_t* rowp = O + (size_t)(row0 + ai * HALF + m * 16) * ldc + col0;
#pragma unroll
                for (int bj = 0; bj < 2; ++bj) { const f32x4 v0 = acc[ai][bj][m][0], v1 = acc[ai][bj][m][1];
                    u32x4 w; w.x = cvt_pk_bf16(v0[0], v0[1]); w.y = cvt_pk_bf16(v0[2], v0[3]); w.z = cvt_pk_bf16(v1[0], v1[1]); w.w = cvt_pk_bf16(v1[2], v1[3]);
                    *(u32x4*)(rowp + bj * HALF) = w; }
            }
    }
};
struct EpiAB {
    static constexpr bool PERM = true, AFTER_DRAIN = false;
    bf16_t* O; int ldc; const float* rcos; const float* rsin; float qscale;
    __device__ __forceinline__ void operator()(const f32x4 (&acc)[2][2][4][2], const Unit& u, int wr, int wc, int fr, int fq) const {
        const int row0 = u.pm * BM + wr * 64 + fr;
        const int kind = (u.pn == 0 || u.pn == 1) ? 0 : (u.pn == 4 || u.pn == 5) ? 1 : (u.pn == 6 || u.pn == 7) ? 2 : 3;
        if (kind <= 1) {
            const float sc = kind == 0 ? qscale : 1.0f;
            const int colb = u.pn * BM + wc * 64 + 8 * fq;
#pragma unroll
            for (int ai = 0; ai < 2; ++ai)
#pragma unroll
                for (int m = 0; m < 4; ++m) {
                    const int row = row0 + ai * HALF + m * 16; const int pos = row & 8191;
                    const f32x4 c0 = *(const f32x4*)(rcos + pos * 32 + 8 * fq), c1 = *(const f32x4*)(rcos + pos * 32 + 8 * fq + 4);
                    const f32x4 s0 = *(const f32x4*)(rsin + pos * 32 + 8 * fq), s1 = *(const f32x4*)(rsin + pos * 32 + 8 * fq + 4);
                    float o1[8], o2[8];
#pragma unroll
                    for (int e = 0; e < 4; ++e) {
                        const float a1 = acc[ai][0][m][0][e], a2 = acc[ai][1][m][0][e], b1 = acc[ai][0][m][1][e], b2 = acc[ai][1][m][1][e];
                        o1[e] = (a1 * c0[e] - a2 * s0[e]) * sc; o2[e] = (a2 * c0[e] + a1 * s0[e]) * sc;
                        o1[4 + e] = (b1 * c1[e] - b2 * s1[e]) * sc; o2[4 + e] = (b2 * c1[e] + b1 * s1[e]) * sc;
                    }
                    bf16_t* rowp = O + (size_t)row * ldc + colb;
                    u32x4 w; w.x = cvt_pk_bf16(o1[0], o1[1]); w.y = cvt_pk_bf16(o1[2], o1[3]); w.z = cvt_pk_bf16(o1[4], o1[5]); w.w = cvt_pk_bf16(o1[6], o1[7]);
                    *(u32x4*)rowp = w;
                    w.x = cvt_pk_bf16(o2[0], o2[1]); w.y = cvt_pk_bf16(o2[2], o2[3]); w.z = cvt_pk_bf16(o2[4], o2[5]); w.w = cvt_pk_bf16(o2[6], o2[7]);
                    *(u32x4*)(rowp + 32) = w;
                }
        } else {
            const int col0 = u.pn * BM + wc * 32 + 8 * fq;
#pragma unroll
            for (int ai = 0; ai < 2; ++ai)
#pragma unroll
                for (int m = 0; m < 4; ++m) {
                    bf16_t* rowp = O + (size_t)(row0 + ai * HALF + m * 16) * ldc + col0;
#pragma unroll
                    for (int bj = 0; bj < 2; ++bj) { f32x4 v0 = acc[ai][bj][m][0], v1 = acc[ai][bj][m][1];
                        if (kind == 3) {
#pragma unroll
                            for (int e = 0; e < 4; ++e) { v0[e] = gelu_tanh(v0[e]); v1[e] = gelu_tanh(v1[e]); } }
                        u32x4 w; w.x = cvt_pk_bf16(v0[0], v0[1]); w.y = cvt_pk_bf16(v0[2], v0[3]); w.z = cvt_pk_bf16(v1[0], v1[1]); w.w = cvt_pk_bf16(v1[2], v1[3]);
                        *(u32x4*)(rowp + bj * HALF) = w; }
                }
        }
    }
};
template <class Epi, class Sched, bool ALIGN_EPI = false, bool SP2 = false>
__device__ __forceinline__ void gemm_phase(PG8_LAS unsigned char* lds, const Gemm g, const Sched& S, const Epi& E) {
    int tid_ = threadIdx.x; asm volatile("" : "+v"(tid_)); const int tid = tid_, wid = __builtin_amdgcn_readfirstlane(tid >> 6), lane = tid & 63, wr = wid >> 2, wc = wid & 3, fr = lane & 15, fq = lane >> 4;
    const int K = g.K, nt = K / BK;
    unsigned voffA[2], voffB[2];
#pragma unroll
    for (int i = 0; i < 2; ++i) { int R, C; stage_rc(tid * 16 + i * 8192, R, C); const int Rb = Epi::PERM ? ((R & ~31) + perm32(R & 31)) : R;
        voffA[i] = (unsigned)(R * g.lda + C) * 2u; voffB[i] = (unsigned)(Rb * K + C) * 2u; }
    const size_t kstep = (size_t)(BK * 2);
    const size_t hstep = (size_t)HALF * K * 2;
    const size_t tstep = 2 * hstep; const size_t hstepA = (size_t)HALF * g.lda * 2, tstepA = 2 * hstepA;
    const unsigned ldsw = (unsigned)wid * 1024u;
    const int aoff = lds_byte(wr * 64 + fr, fq * 8), boff = lds_byte(wc * 32 + fr, fq * 8);
#define PG8_SA(b, h) (((b) * 2 + (h)) * HTB)
#define PG8_SB(b, h) ((4 + (b) * 2 + (h)) * HTB)
#define PG8_STAGE(bufoff, gbase, voff) do { _Pragma("unroll") for (int _i = 0; _i < 2; ++_i) \
        __builtin_amdgcn_global_load_lds((const unsigned*)((const char*)(gbase) + (voff)[_i]), (PG8_LAS unsigned*)(lds + (bufoff) + ldsw + _i * 8192), 16, 0, 0); } while (0)
#define PG8_LDA(dst, b, h) do { _Pragma("unroll") for (int m = 0; m < 4; ++m) _Pragma("unroll") for (int k = 0; k < 2; ++k) dst[m][k] = *(const PG8_LAS bf16x8*)(lds + PG8_SA(b, h) + aoff + m * 2048 + k * 1024); } while (0)
#define PG8_LDB(dst, b, h) do { _Pragma("unroll") for (int n = 0; n < 2; ++n) _Pragma("unroll") for (int k = 0; k < 2; ++k) dst[n][k] = *(const PG8_LAS bf16x8*)(lds + PG8_SB(b, h) + boff + n * 2048 + k * 1024); } while (0)
#define PG8_MMA(ai, bj, At, Bt) do { __builtin_amdgcn_s_setprio(1); _Pragma("unroll") for (int m = 0; m < 4; ++m) _Pragma("unroll") for (int n = 0; n < 2; ++n) _Pragma("unroll") for (int k = 0; k < 2; ++k) \
        acc[ai][bj][m][n] = __builtin_amdgcn_mfma_f32_16x16x32_bf16(Bt[n][k], At[m][k], acc[ai][bj][m][n], 0, 0, 0); __builtin_amdgcn_s_setprio(0); } while (0)
#define PG8_WAIT_V(n) asm volatile("s_waitcnt vmcnt(" #n ")" ::: "memory")
#define PG8_WAIT_L(n) asm volatile("s_waitcnt lgkmcnt(" #n ")" ::: "memory")
#define PG8_BAR __builtin_amdgcn_s_barrier()
#define PG8_SCHED __builtin_amdgcn_sched_barrier(0)
    Unit cur, nxt; int ui = 0;
    if (!S.next(0, cur)) return;
    f32x4 acc[2][2][4][2];
#pragma unroll
    for (int a = 0; a < 2; ++a)
#pragma unroll
        for (int b = 0; b < 2; ++b)
#pragma unroll
            for (int m = 0; m < 4; ++m)
#pragma unroll
                for (int n = 0; n < 2; ++n) acc[a][b][m][n] = (f32x4){0.f, 0.f, 0.f, 0.f};
    bf16x8 At[4][2], B0[2][2], B1[2][2];
    const char* cA = (const char*)g.A + (size_t)cur.pm * tstepA; const char* cB = (const char*)g.Bt + (size_t)cur.pn * tstep;
    S.a_ready(cur);
    if constexpr (SP2) {
        PG8_STAGE(PG8_SB(0, 0), cB, voffB); PG8_STAGE(PG8_SB(0, 1), cB + hstep, voffB); PG8_STAGE(PG8_SA(0, 0), cA, voffA); PG8_STAGE(PG8_SA(0, 1), cA + hstepA, voffA);
        if (wr == 1) PG8_BAR;
        PG8_WAIT_V(2); PG8_BAR;
        PG8_STAGE(PG8_SB(1, 0), cB + kstep, voffB); PG8_STAGE(PG8_SA(1, 0), cA + kstep, voffA); PG8_STAGE(PG8_SB(1, 1), cB + hstep + kstep, voffB);
        PG8_WAIT_V(6); PG8_BAR;
    } else {
        PG8_STAGE(PG8_SB(0, 0), cB, voffB); PG8_STAGE(PG8_SA(0, 0), cA, voffA); PG8_STAGE(PG8_SB(0, 1), cB + hstep, voffB); PG8_STAGE(PG8_SA(0, 1), cA + hstepA, voffA);
        if (wr == 1) PG8_BAR;
        PG8_WAIT_V(4); PG8_BAR;
        PG8_STAGE(PG8_SB(1, 0), cB + kstep, voffB); PG8_STAGE(PG8_SA(1, 0), cA + kstep, voffA); PG8_STAGE(PG8_SB(1, 1), cB + hstep + kstep, voffB);
        PG8_WAIT_V(6); PG8_BAR;
    }
    for (;;) {
        const bool has_next = S.next(ui + 1, nxt);
        const char* nA = has_next ? (const char*)g.A + (size_t)nxt.pm * tstepA : cA; const char* nB = has_next ? (const char*)g.Bt + (size_t)nxt.pn * tstep : cB;
        for (int t = 0; t < nt; t += 2) {
            const bool last = (t == nt - 2);
            const char* a1 = cA + (size_t)(t + 1) * kstep;
            const char* a2 = last ? nA : cA + (size_t)(t + 2) * kstep; const char* b2 = last ? nB : cB + (size_t)(t + 2) * kstep;
            const char* a3 = a2 + kstep; const char* b3 = b2 + kstep;
            if (last && has_next) S.a_ready(nxt);
            if constexpr (SP2) {
            PG8_LDB(B0, 0, 0); PG8_LDB(B1, 0, 1); PG8_SCHED; PG8_LDA(At, 0, 0); PG8_STAGE(PG8_SA(1, 1), a1 + hstepA, voffA);
            PG8_WAIT_V(8); PG8_WAIT_L(0); PG8_BAR; PG8_MMA(0, 0, At, B0); PG8_MMA(0, 1, At, B1); PG8_BAR; PG8_SCHED;
            PG8_LDA(At, 0, 1); PG8_STAGE(PG8_SB(0, 0), b2, voffB); PG8_STAGE(PG8_SB(0, 1), b2 + hstep, voffB); PG8_STAGE(PG8_SA(0, 0), a2, voffA);
            PG8_WAIT_V(8); PG8_WAIT_L(0); PG8_BAR; PG8_MMA(1, 0, At, B0); PG8_MMA(1, 1, At, B1); PG8_BAR; PG8_SCHED;
            PG8_LDB(B0, 1, 0); PG8_LDB(B1, 1, 1); PG8_SCHED; PG8_LDA(At, 1, 0); PG8_STAGE(PG8_SA(0, 1), a2 + hstepA, voffA);
            PG8_WAIT_V(8); PG8_WAIT_L(0); PG8_BAR; PG8_MMA(0, 0, At, B0); PG8_MMA(0, 1, At, B1); PG8_BAR; PG8_SCHED;
            PG8_LDA(At, 1, 1); PG8_STAGE(PG8_SB(1, 0), b3, voffB); PG8_STAGE(PG8_SB(1, 1), b3 + hstep, voffB); PG8_STAGE(PG8_SA(1, 0), a3, voffA);
            PG8_WAIT_V(8); PG8_WAIT_L(0); PG8_BAR; PG8_MMA(1, 0, At, B0); PG8_MMA(1, 1, At, B1); PG8_BAR; PG8_SCHED;
            } else {
            PG8_LDB(B0, 0, 0); PG8_SCHED; PG8_LDA(At, 0, 0); PG8_STAGE(PG8_SA(1, 1), a1 + hstepA, voffA);
            PG8_WAIT_L(8); PG8_BAR; PG8_WAIT_L(0); PG8_MMA(0, 0, At, B0); PG8_BAR; PG8_SCHED;
            PG8_LDB(B1, 0, 1); PG8_STAGE(PG8_SB(0, 0), b2, voffB);
            PG8_BAR; PG8_WAIT_L(0); PG8_MMA(0, 1, At, B1); PG8_BAR;
            PG8_LDA(At, 0, 1); PG8_STAGE(PG8_SA(0, 0), a2, voffA);
            PG8_BAR; PG8_WAIT_L(0); PG8_MMA(1, 0, At, B0); PG8_BAR; PG8_SCHED;
            PG8_STAGE(PG8_SB(0, 1), b2 + hstep, voffB);
            PG8_WAIT_V(6); PG8_BAR; PG8_MMA(1, 1, At, B1); PG8_BAR;
            PG8_LDB(B0, 1, 0); PG8_SCHED; PG8_LDA(At, 1, 0); PG8_STAGE(PG8_SA(0, 1), a2 + hstepA, voffA);
            PG8_WAIT_L(8); PG8_BAR; PG8_WAIT_L(0); PG8_MMA(0, 0, At, B0); PG8_BAR; PG8_SCHED;
            PG8_LDB(B1, 1, 1); PG8_STAGE(PG8_SB(1, 0), b3, voffB);
            PG8_BAR; PG8_WAIT_L(0); PG8_MMA(0, 1, At, B1); PG8_BAR;
            PG8_LDA(At, 1, 1); PG8_STAGE(PG8_SA(1, 0), a3, voffA);
            PG8_BAR; PG8_WAIT_L(0); PG8_MMA(1, 0, At, B0); PG8_BAR; PG8_SCHED;
            PG8_STAGE(PG8_SB(1, 1), b3 + hstep, voffB);
            PG8_WAIT_V(6); PG8_BAR; PG8_MMA(1, 1, At, B1); PG8_BAR;
            }
        }
        if constexpr (ALIGN_EPI) { if (wr == 0) PG8_BAR; }
        if constexpr (!Epi::AFTER_DRAIN) { E(acc, cur, wr, wc, fr, fq); S.done(cur); }
        if (!has_next) break;
#pragma unroll
        for (int a = 0; a < 2; ++a)
#pragma unroll
            for (int b = 0; b < 2; ++b)
#pragma unroll
                for (int m = 0; m < 4; ++m)
#pragma unroll
                    for (int n = 0; n < 2; ++n) acc[a][b][m][n] = (f32x4){0.f, 0.f, 0.f, 0.f};
        cur = nxt; cA = nA; cB = nB; ++ui;
        if constexpr (ALIGN_EPI) { if (wr == 1) PG8_BAR; }
    }
    PG8_WAIT_V(0);
    if constexpr (!ALIGN_EPI) { if (wr == 0) PG8_BAR; }
    PG8_BAR;
    if constexpr (Epi::AFTER_DRAIN) { E.fused(acc, cur, wr, wc, fr, fq, lds, wid, lane); S.done(cur); }
#undef PG8_SA
#undef PG8_SB
#undef PG8_STAGE
#undef PG8_LDA
#undef PG8_LDB
#undef PG8_MMA
#undef PG8_WAIT_V
#undef PG8_WAIT_L
#undef PG8_BAR
#undef PG8_SCHED
}
}
namespace attn_body {
using bf16=__hip_bfloat16;
using bf16x8=__attribute__((ext_vector_type(8)))short;
using s16x4=__attribute__((ext_vector_type(4)))short;
using f32x16=__attribute__((ext_vector_type(16)))float;
using u32x4=__attribute__((ext_vector_type(4)))unsigned;
constexpr int BATCH=4,NHEAD=8,SEQ=8192,D=64,DM=2560;
constexpr int NW=8,QBLK=32,QB=QBLK*NW,KVBLK=64,NQB=SEQ/QB;
constexpr int ATTN_PITCH=DM, ATTN_UNIT_ROWS=QB;
__device__ __forceinline__ int crow(int r,int hi){return (r&3)+8*(r>>2)+4*hi;}
#define SBAR() __builtin_amdgcn_sched_barrier(0)
__device__ __forceinline__ void cmask(f32x16&p0,f32x16&p1,int jb,int qrel,int hi){
  const float NEG=-INFINITY; int kb=64*jb+4*hi;
  #pragma unroll
  for(int r=0;r<16;++r){int kv=kb+(r&3)+8*(r>>2); if(kv>qrel)p0[r]=NEG; if(kv+32>qrel)p1[r]=NEG;}
}

constexpr int NSLOT=3, SLOTB=8192;
constexpr int LDS_K=0, LDS_V=NSLOT*SLOTB, LDS_WS=2*NSLOT*SLOTB, LDS_OST=LDS_WS+NW*128*4, LDS_BYTES=LDS_OST+NW*4096;
constexpr float C2=0.125f*1.4426950408889634f;
__device__ __forceinline__ void glds16(const void*gsrc,unsigned lds_dst){unsigned keep;
  asm volatile("s_mov_b32 %0, m0\n\ts_mov_b32 m0, %2\n\ts_nop 0\n\tglobal_load_lds_dwordx4 %1, off\n\ts_mov_b32 m0, %0":"=&s"(keep):"v"(gsrc),"s"(lds_dst):"memory");}
__device__ __forceinline__ float max3f(float a,float b,float c){float r;asm("v_max3_f32 %0, %1, %2, %3":"=v"(r):"v"(a),"v"(b),"v"(c));return r;}
__device__ __forceinline__ float max2f(float a,float b){float r;asm("v_max_f32_e32 %0, %1, %2":"=v"(r):"v"(a),"v"(b));return r;}
__device__ __forceinline__ float fadd_s(float a,float b){float r;asm("v_add_f32_e32 %0, %1, %2":"=v"(r):"v"(a),"v"(b));return r;}
__device__ __forceinline__ float fsub_s(float a,float b){float r;asm("v_sub_f32_e32 %0, %1, %2":"=v"(r):"v"(a),"v"(b));return r;}
typedef float f32x2_t __attribute__((ext_vector_type(2))); typedef __bf16 bf16x2_t __attribute__((ext_vector_type(2)));
__device__ __forceinline__ unsigned cvtpk_s(float lo,float hi){f32x2_t v={lo,hi};bf16x2_t b=__builtin_convertvector(v,bf16x2_t);return __builtin_bit_cast(unsigned,b);}
#define WAIT_BAR(N) asm volatile("s_waitcnt vmcnt(" #N ") lgkmcnt(0)\n\ts_barrier":::"memory")

__device__ __forceinline__ void qkt(f32x16&p0,f32x16&p1,const char*Kslot,const bf16x8*qr,const f32x16&negm,int r32,int hi){
  const char*kb=Kslot+hi*1024+r32*16;
  #pragma unroll
  for(int d0=0;d0<4;++d0){
    const bf16x8 b0=*reinterpret_cast<const bf16x8*>(kb+d0*2048);
    const bf16x8 b1=*reinterpret_cast<const bf16x8*>(kb+d0*2048+512);
    if(d0==0){p0=__builtin_amdgcn_mfma_f32_32x32x16_bf16(b0,qr[0],negm,0,0,0);p1=__builtin_amdgcn_mfma_f32_32x32x16_bf16(b1,qr[0],negm,0,0,0);}
    else{p0=__builtin_amdgcn_mfma_f32_32x32x16_bf16(b0,qr[d0],p0,0,0,0);p1=__builtin_amdgcn_mfma_f32_32x32x16_bf16(b1,qr[d0],p1,0,0,0);}}
}
typedef __attribute__((address_space(3))) const char* lds_cptr;
typedef short v4i16_t __attribute__((ext_vector_type(4)));
__device__ __forceinline__ void kload8(bf16x8*kf,lds_cptr kp){
  kf[0]=*(const __attribute__((address_space(3))) bf16x8*)(kp);      kf[1]=*(const __attribute__((address_space(3))) bf16x8*)(kp+512);
  kf[2]=*(const __attribute__((address_space(3))) bf16x8*)(kp+2048); kf[3]=*(const __attribute__((address_space(3))) bf16x8*)(kp+2560);
  kf[4]=*(const __attribute__((address_space(3))) bf16x8*)(kp+4096); kf[5]=*(const __attribute__((address_space(3))) bf16x8*)(kp+4608);
  kf[6]=*(const __attribute__((address_space(3))) bf16x8*)(kp+6144); kf[7]=*(const __attribute__((address_space(3))) bf16x8*)(kp+6656);
}
__device__ __forceinline__ void kload2(bf16x8*kf,lds_cptr kp,int j){ kf[2*j]=*(const __attribute__((address_space(3))) bf16x8*)(kp+j*2048); kf[2*j+1]=*(const __attribute__((address_space(3))) bf16x8*)(kp+j*2048+512); }
__device__ __forceinline__ s16x4 vtr(lds_cptr p){ return __builtin_bit_cast(s16x4,__builtin_amdgcn_ds_read_tr16_b64_v4i16((__attribute__((address_space(3))) v4i16_t*)p)); }
__device__ __forceinline__ float rowmax(const f32x16&p0,const f32x16&p1){
  float a=max3f(p0[0],p0[1],p1[0]),b=max3f(p0[2],p0[3],p1[1]);a=max3f(a,p1[2],p1[3]);
  #pragma unroll
  for(int r=4;r<16;r+=4){a=max3f(a,p0[r],p0[r+1]);b=max3f(b,p0[r+2],p0[r+3]);a=max3f(a,p1[r],p1[r+1]);b=max3f(b,p1[r+2],p1[r+3]);}
  const float m=max2f(a,b);
  auto rr=__builtin_amdgcn_permlane32_swap(__float_as_uint(m),__float_as_uint(m),false,false);
  return max2f(__uint_as_float(rr[0]),__uint_as_float(rr[1]));
}
__device__ __forceinline__ void pv(f32x16*o,int vb,bf16x8 pa0,bf16x8 pa1,bf16x8 pa2,bf16x8 pa3){
  #pragma unroll
  for(int d0=0;d0<2;++d0){s16x4 lo[4],hi[4];
    #pragma unroll
    for(int ks=0;ks<4;++ks){
      asm volatile("ds_read_b64_tr_b16 %0,%1 offset:%c2":"=&v"(lo[ks]):"v"(vb),"i"(d0*4096+ks*1024):"memory");
      asm volatile("ds_read_b64_tr_b16 %0,%1 offset:%c2":"=&v"(hi[ks]):"v"(vb),"i"(d0*4096+ks*1024+512):"memory");}
    asm volatile("s_waitcnt lgkmcnt(0)":::"memory");SBAR();
    #define PK(k) (bf16x8){lo[k][0],lo[k][1],lo[k][2],lo[k][3],hi[k][0],hi[k][1],hi[k][2],hi[k][3]}
    o[d0]=__builtin_amdgcn_mfma_f32_32x32x16_bf16(pa0,PK(0),o[d0],0,0,0);
    o[d0]=__builtin_amdgcn_mfma_f32_32x32x16_bf16(pa1,PK(1),o[d0],0,0,0);
    o[d0]=__builtin_amdgcn_mfma_f32_32x32x16_bf16(pa2,PK(2),o[d0],0,0,0);
    o[d0]=__builtin_amdgcn_mfma_f32_32x32x16_bf16(pa3,PK(3),o[d0],0,0,0);
    #undef PK
  }
}

#ifndef ATTN_STORE16
#define ATTN_STORE16(p,v) (*(u32x4*)(p)=(v))
#endif
template<int THRL> __device__ __forceinline__ void attn_unit(int b,int h,int qb,const bf16*Q,const bf16*__restrict__ K,const bf16*__restrict__ V,bf16*O,const unsigned*__restrict__ SEL,char*shm){
  int tid_=threadIdx.x; asm volatile("":"+v"(tid_)); const int tid=tid_,lane=tid&63,r32=lane&31,hi=lane>>5; const int wid=__builtin_amdgcn_readfirstlane(tid>>6);
  const long rowbase=(long)b*SEQ; const int q0=qb*QB;
  const bf16*Qw=Q+(rowbase+q0+wid*QBLK)*DM+h*D;
  const bf16*Kh=K+rowbase*DM+h*D,*Vh=V+rowbase*DM+h*D;
  const unsigned lds0=(unsigned)(uintptr_t)shm;
  float*wsf=(float*)(shm+LDS_WS)+wid*128;
  const bf16*ksrc=Kh+(long)lane*DM+wid*8;
  const bf16*vsrc=Vh+(long)(16*(wid&3)+(lane>>2))*DM+(wid>>2)*32+(lane&3)*8;
  const unsigned kdst=lds0+LDS_K+wid*1024, vdst=lds0+LDS_V+wid*1024;
  #define DMA_K(t,slot) glds16(ksrc+(long)(t)*KVBLK*DM,(unsigned)__builtin_amdgcn_readfirstlane(kdst+(slot)))
  #define DMA_V(t,slot) glds16(vsrc+(long)(t)*KVBLK*DM,(unsigned)__builtin_amdgcn_readfirstlane(vdst+(slot)))
  const int vb0=(int)(lds0+LDS_V)+((lane>>4)&1)*32+(lane&3)*8+(4*hi+((lane&15)>>2))*64;
  const char*Kbase=shm+LDS_K; bf16x8 kf[8];
  const lds_cptr shm3=(lds_cptr)shm; const lds_cptr kp0=shm3+LDS_K+hi*1024+r32*16; const lds_cptr vp0=shm3+LDS_V+((lane>>4)&1)*32+(lane&3)*8+(4*hi+((lane&15)>>2))*64;
  const int NT=(q0+QB)/KVBLK;
  DMA_K(0,0);DMA_V(0,0);DMA_K(1,SLOTB);
  bf16x8 qr[4];
  #pragma unroll
  for(int d0=0;d0<4;++d0)qr[d0]=*reinterpret_cast<const bf16x8*>(&Qw[(long)r32*DM+d0*16+hi*8]);
  float mhat=0.f,l_reg=0.f;f32x16 o[2];o[0]=f32x16{};o[1]=f32x16{};const f32x16 negm=f32x16{};
  const int qrel=wid*QBLK+r32;
  unsigned*selp=(unsigned*)(wsf+64);
  if(hi==0)selp[r32]=SEL[(size_t)(rowbase+q0+qrel)*NHEAD+h];
  #define MOBA(P0,P1,t) do{ const unsigned sel_=selp[r32]; if(!((sel_>>((t)>>2))&1u)){ _Pragma("unroll") for(int r_=0;r_<16;++r_){P0[r_]=-INFINITY;P1[r_]=-INFINITY;} } }while(0)
  #define CMASK(P0,P1,t) do{int jb_=(t)-(NT-4); if(jb_>=0)cmask(P0,P1,jb_,qrel,hi); else MOBA(P0,P1,t);}while(0)
  bool resc=false;
  #define START(P0,P1) do{ const float rm=rowmax(P0,P1); resc=false; \
    { const float dl=(rm==-INFINITY)?0.f:rm; mhat=fadd_s(mhat,dl); \
      _Pragma("unroll") for(int r=0;r<16;++r){P0[r]=fsub_s(P0[r],dl);P1[r]=fsub_s(P1[r],dl);} \
      } \
    _Pragma("unroll") for(int r=0;r<16;++r)P0[r]=__builtin_amdgcn_exp2f(P0[r]); }while(0)
  #define RESC() do{ if(resc){ asm volatile("s_waitcnt lgkmcnt(0)":::"memory"); \
      _Pragma("unroll") for(int d_=0;d_<2;++d_) _Pragma("unroll") for(int r=0;r<16;++r)o[d_][r]*=wsf[crow(r,hi)]; } }while(0)
  f32x16 pA0,pA1,pB0,pB1;
  int sl_prev=0,sl_cur=0,sl_next=SLOTB;
  #define ROT() do{sl_prev=sl_cur;sl_cur=sl_next;sl_next=(sl_next==(NSLOT-1)*SLOTB)?0:sl_next+SLOTB;}while(0)
  DMA_K(2,2*SLOTB);
  WAIT_BAR(3);
  qkt(pA0,pA1,Kbase,qr,negm,r32,hi);asm volatile("s_nop 15\n\ts_nop 7":"+v"(pA0),"+v"(pA1));CMASK(pA0,pA1,0);
  START(pA0,pA1);
  _Pragma("unroll") for(int r=0;r<16;++r)pA1[r]=__builtin_amdgcn_exp2f(pA1[r]);
  WAIT_BAR(0);
  DMA_K(3,0);DMA_V(1,SLOTB);
  ROT();
  kload8(kf,kp0+sl_cur);
  WAIT_BAR(2);
  s16x4 vlo[8],vhi[8]; u32x4 pw0,pw1,pw2,pw3;
  #define PKW(P,B) cvtpk_s(P[B],P[B+1])
  #define PAF(k) __builtin_bit_cast(bf16x8,pw##k)
  #define VFR(i) (bf16x8){vlo[i][0],vlo[i][1],vlo[i][2],vlo[i][3],vhi[i][0],vhi[i][1],vhi[i][2],vhi[i][3]}
  #define PIN(x) asm volatile("":"+v"(x))
  #define MX3(a,b,c) __builtin_fmaxf(__builtin_fmaxf((a),(b)),(c))
  #define GAPA(MF,A0,A1,A2,A3,W0,W1,PW) do{ MF; sacc+=A0; sacc+=A1; sacc+=A2; sacc+=A3; PIN(sacc); W0; W1; PIN(PW); SBAR(); }while(0)
  #define EX(v) __builtin_amdgcn_exp2f(v)
  #define GAPB(MF,X,B) do{ MF; X[B]=EX(X[B]); X[B+1]=EX(X[B+1]); X[B+2]=EX(X[B+2]); X[B+3]=EX(X[B+3]); PIN(X); SBAR(); }while(0)
  #define VRD(i) do{ vlo[i]=vtr(vp_+(((i)>>2)*4096+((i)&3)*1024)); vhi[i]=vtr(vp_+(((i)>>2)*4096+((i)&3)*1024+512)); }while(0)
  #define KRD(G,j) do{ if(G){ kload2(kf,kp0+sl_next,j); SBAR(); } }while(0)
  #define STEP(C0,C1,P0,P1,t,GK,GV,GL) do{ SBAR(); \
    const lds_cptr vp_=vp0+sl_prev; \
    VRD(0); SBAR(); float sacc=(P0[0]+P0[1]); \
    GAPA(C0=__builtin_amdgcn_mfma_f32_32x32x16_bf16(kf[0],qr[0],negm,0,0,0), P0[2],P0[3],P0[4],P0[5],     pw0[0]=PKW(P0,0), pw0[1]=PKW(P0,2), pw0); \
    VRD(4); SBAR(); GAPA(C1=__builtin_amdgcn_mfma_f32_32x32x16_bf16(kf[1],qr[0],negm,0,0,0), P0[6],P0[7],P0[8],P0[9],     pw0[2]=PKW(P0,4), pw0[3]=PKW(P0,6), pw0); \
    VRD(1); SBAR(); GAPA(C0=__builtin_amdgcn_mfma_f32_32x32x16_bf16(kf[2],qr[1],C0,0,0,0),   P0[10],P0[11],P0[12],P0[13], pw1[0]=PKW(P0,8), pw1[1]=PKW(P0,10), pw1); \
    VRD(5); SBAR(); GAPA(C1=__builtin_amdgcn_mfma_f32_32x32x16_bf16(kf[3],qr[1],C1,0,0,0),   P0[14],P0[15],P1[0],P1[1],   pw1[2]=PKW(P0,12),pw1[3]=PKW(P0,14), pw1); \
    VRD(2); SBAR(); GAPA(C0=__builtin_amdgcn_mfma_f32_32x32x16_bf16(kf[4],qr[2],C0,0,0,0),   P1[2],P1[3],P1[4],P1[5],     pw2[0]=PKW(P1,0), pw2[1]=PKW(P1,2), pw2); \
    VRD(6); SBAR(); GAPA(C1=__builtin_amdgcn_mfma_f32_32x32x16_bf16(kf[5],qr[2],C1,0,0,0),   P1[6],P1[7],P1[8],P1[9],     pw2[2]=PKW(P1,4), pw2[3]=PKW(P1,6), pw2); \
    VRD(3); SBAR(); GAPA(C0=__builtin_amdgcn_mfma_f32_32x32x16_bf16(kf[6],qr[3],C0,0,0,0),   P1[10],P1[11],P1[12],P1[13], pw3[0]=PKW(P1,8), pw3[1]=PKW(P1,10), pw3); \
    VRD(7); SBAR(); GAPA(C1=__builtin_amdgcn_mfma_f32_32x32x16_bf16(kf[7],qr[3],C1,0,0,0),   P1[14],P1[15],0.f,0.f,       pw3[2]=PKW(P1,12),pw3[3]=PKW(P1,14), pw3); \
    l_reg+=sacc; \
    if(GK){DMA_K((t)+3,sl_cur);} if(GV){DMA_V((t)+1,sl_next);} \
    _Pragma("unroll") for(int r=0;r<16;++r){C0[r]-=mhat;C1[r]-=mhat;} \
    CMASK(C0,C1,t); \
    { float a=MX3(C0[0],C0[1],C1[0]),b=MX3(C0[2],C0[3],C1[1]); a=MX3(a,C1[2],C1[3]); \
      _Pragma("unroll") for(int r=4;r<16;r+=4){a=MX3(a,C0[r],C0[r+1]);b=MX3(b,C0[r+2],C0[r+3]);a=MX3(a,C1[r],C1[r+1]);b=MX3(b,C1[r+2],C1[r+3]);} \
      float rm=__builtin_fmaxf(a,b); { auto rr=__builtin_amdgcn_permlane32_swap(__float_as_uint(rm),__float_as_uint(rm),false,false); rm=__builtin_fmaxf(__uint_as_float(rr[0]),__uint_as_float(rr[1])); } \
      resc=false; \
      if(__builtin_expect(__any(rm>(float)THRL),0)){ const float dl=__builtin_fmaxf(rm,0.f); mhat+=dl; \
        _Pragma("unroll") for(int r=0;r<16;++r){C0[r]-=dl;C1[r]-=dl;} \
        const float f=__builtin_amdgcn_exp2f(-dl); l_reg*=f; if(hi==0)wsf[r32]=f; resc=true; } } \
    SBAR(); \
    GAPB(o[0]=__builtin_amdgcn_mfma_f32_32x32x16_bf16(PAF(0),VFR(0),o[0],0,0,0), C0,0); \
    GAPB(o[1]=__builtin_amdgcn_mfma_f32_32x32x16_bf16(PAF(0),VFR(4),o[1],0,0,0), C0,4); \
    KRD(GL,0); GAPB(o[0]=__builtin_amdgcn_mfma_f32_32x32x16_bf16(PAF(1),VFR(1),o[0],0,0,0), C0,8); \
    KRD(GL,1); GAPB(o[1]=__builtin_amdgcn_mfma_f32_32x32x16_bf16(PAF(1),VFR(5),o[1],0,0,0), C0,12); \
    KRD(GL,2); GAPB(o[0]=__builtin_amdgcn_mfma_f32_32x32x16_bf16(PAF(2),VFR(2),o[0],0,0,0), C1,0); \
    KRD(GL,3); GAPB(o[1]=__builtin_amdgcn_mfma_f32_32x32x16_bf16(PAF(2),VFR(6),o[1],0,0,0), C1,4); \
    GAPB(o[0]=__builtin_amdgcn_mfma_f32_32x32x16_bf16(PAF(3),VFR(3),o[0],0,0,0), C1,8); \
    GAPB(o[1]=__builtin_amdgcn_mfma_f32_32x32x16_bf16(PAF(3),VFR(7),o[1],0,0,0), C1,12); \
    }while(0)
  int t=1;
  #undef CMASK
  #define CMASK(P0,P1,t) MOBA(P0,P1,t)
  for(;t+5<NT;t+=2){
    STEP(pB0,pB1,pA0,pA1,t,true,true,true);     WAIT_BAR(2); RESC(); ROT();
    STEP(pA0,pA1,pB0,pB1,t+1,true,true,true);   WAIT_BAR(2); RESC(); ROT();
  }
  #undef CMASK
  #define CMASK(P0,P1,t) do{int jb_=(t)-(NT-4); if(jb_>=0)cmask(P0,P1,jb_,qrel,hi); else MOBA(P0,P1,t);}while(0)
  #define ENDW(tt) do{ if((tt)+3<NT){WAIT_BAR(2);} else if((tt)+2<NT){WAIT_BAR(1);} else {WAIT_BAR(0);} }while(0)
  for(;t+1<NT;t+=2){
    STEP(pB0,pB1,pA0,pA1,t,(t+3<NT),(t+1<NT),(t+1<NT));       ENDW(t);   RESC(); ROT();
    STEP(pA0,pA1,pB0,pB1,t+1,(t+4<NT),(t+2<NT),(t+2<NT));     ENDW(t+1); RESC(); ROT();
  }
  STEP(pB0,pB1,pA0,pA1,NT-1,false,false,false); RESC();
  { float sacc=pB0[0]+pB0[1]; _Pragma("unroll") for(int r=2;r<16;++r)sacc+=pB0[r]; _Pragma("unroll") for(int r=0;r<16;++r)sacc+=pB1[r]; l_reg+=sacc;
    pw0=(u32x4){PKW(pB0,0),PKW(pB0,2),PKW(pB0,4),PKW(pB0,6)};pw1=(u32x4){PKW(pB0,8),PKW(pB0,10),PKW(pB0,12),PKW(pB0,14)};pw2=(u32x4){PKW(pB1,0),PKW(pB1,2),PKW(pB1,4),PKW(pB1,6)};pw3=(u32x4){PKW(pB1,8),PKW(pB1,10),PKW(pB1,12),PKW(pB1,14)};
    SBAR(); pv(o,vb0+sl_cur,PAF(0),PAF(1),PAF(2),PAF(3)); }
  #undef PKW
  #undef PAF
  #undef VFR
  #undef PIN
  #undef MX3
  #undef GAPA
  #undef GAPB
  #undef EX
  #undef VRD
  #undef KRD
  #undef STEP
  #undef ENDW
  {auto rr=__builtin_amdgcn_permlane32_swap(__float_as_uint(l_reg),__float_as_uint(l_reg),false,false);l_reg=__uint_as_float(rr[0])+__uint_as_float(rr[1]);}
  if(hi==0)wsf[32+r32]=l_reg;asm volatile("s_waitcnt lgkmcnt(0)":::"memory");
  float rli[16];
  #pragma unroll
  for(int r=0;r<16;++r)rli[r]=__builtin_amdgcn_rcpf(wsf[32+crow(r,hi)]);
  bf16*Ow=O+(rowbase+q0+wid*QBLK)*DM+h*D;
  { bf16*stg=(bf16*)(shm+LDS_OST)+wid*2048;
    #pragma unroll
    for(int r=0;r<16;++r){const int orow=crow(r,hi);
      #pragma unroll
      for(int d0=0;d0<2;++d0)stg[orow*64+d0*32+r32]=__float2bfloat16(o[d0][r]*rli[r]);}
    asm volatile("s_waitcnt lgkmcnt(0)":::"memory");
    #pragma unroll
    for(int i=0;i<4;++i){const int row=i*8+(lane>>3),ch=lane&7; const u32x4 v=*(const u32x4*)(stg+row*64+ch*8); ATTN_STORE16(Ow+(long)row*DM+ch*8,v);} }
  asm volatile("s_waitcnt lgkmcnt(0)\n\ts_barrier":::"memory");
  #undef DMA_K
  #undef DMA_V
  #undef CMASK
  #undef MOBA
  #undef START
  #undef RESC
  #undef ROT
}
constexpr int ATTN_LDS_BYTES=LDS_BYTES;
struct AttnTensors { const bf16* Q; const bf16* K; const bf16* V; bf16* O; const unsigned* SEL; };
struct AttnUnit { int bh; int qb; };
struct StaticOrder {
  int vcu;
  __device__ __forceinline__ explicit StaticOrder(int grid,int block):vcu((block%8)*(grid/8)+block/8){}
  __device__ __forceinline__ bool next(int i,AttnUnit&u)const{ if(i>=4)return false; const int s=vcu&7; u.bh=vcu>>3; u.qb=(i==0)?s:(i==1)?15-s:(i==2)?16+s:31-s; return true; }
  __device__ __forceinline__ void a_ready(const AttnUnit&)const{}
  __device__ __forceinline__ void done(const AttnUnit&)const{}
};
template<class Sched,int THRL=8> __device__ __forceinline__ void attn_phase(char*lds,const AttnTensors&T,const Sched&S){
  AttnUnit u;
  for(int i=0;S.next(i,u);++i){ S.a_ready(u); attn_unit<THRL>(u.bh/NHEAD,u.bh%NHEAD,u.qb,T.Q,T.K,T.V,T.O,T.SEL,lds); S.done(u); }
}
#undef SBAR
#undef WAIT_BAR
}
#define LAS __attribute__((address_space(3)))
typedef unsigned short bf16_t;
typedef unsigned v4u __attribute__((ext_vector_type(4)));
typedef unsigned v2u __attribute__((ext_vector_type(2)));
typedef float f32x4 __attribute__((ext_vector_type(4)));
typedef short bf16x8 __attribute__((ext_vector_type(8)));

constexpr int NB = 4, SEQ = 8192, T = NB * SEQ, D = 1024, FF = 2816;
constexpr int AB_IN = 2560, C_INW = 3080, C_PROJ = 3072;
constexpr float ALPHA = 1.4142135623730951f;
constexpr float LN_EPS = 1e-5f;
constexpr int NWAVES = 8;
constexpr size_t MiB = 1u << 20;
constexpr size_t WS_ROPE = 1 * MiB;
constexpr size_t WS_WGU = 3 * MiB;
constexpr size_t WS_WD = WS_WGU + 44 * MiB;
constexpr size_t WS_WABI = WS_WD + 22 * MiB;
constexpr size_t WS_WABO = WS_WABI + 5 * MiB;
constexpr size_t WS_WCI = WS_WABO + 2 * MiB;
constexpr size_t WS_WCO = WS_WCI + 6 * MiB;
constexpr size_t WS_SMALL = WS_WCO + 2 * MiB;
constexpr size_t WS_KMEAN = WS_SMALL;
constexpr size_t WS_STATS = WS_SMALL + 1 * MiB;
constexpr size_t WS_SEL = WS_SMALL + 2 * MiB;
constexpr size_t WS_GATES = WS_SMALL + 3 * MiB;
constexpr size_t WS_WIF = WS_SMALL + 4 * MiB;
constexpr size_t WS_BEND = WS_SMALL + 5 * MiB;
constexpr size_t WS_AMAX = WS_BEND + 8192;
constexpr size_t WS_MIN = WS_AMAX + 8192;
constexpr size_t WS_KS = WS_SMALL + 6 * MiB;
constexpr size_t WS_NIN = WS_SMALL + 7 * MiB;
constexpr size_t WS_XB = 96 * MiB;
constexpr size_t WS_BIG = 160 * MiB;
constexpr size_t WS_Y = 352 * MiB;
constexpr size_t WS_END = 480 * MiB;
static_assert(WS_SMALL + 8 * MiB <= WS_XB, "ws map");
constexpr int LDS_BYTES = 147456, LDS_MISC = 147456 - 256;

__device__ __forceinline__ unsigned f2bf(float f) { unsigned u = __builtin_bit_cast(unsigned, f); return (u + 0x7fffu + ((u >> 16) & 1u)) >> 16; }
__device__ __forceinline__ unsigned pk2(float lo, float hi) { return f2bf(lo) | (f2bf(hi) << 16); }
__device__ __forceinline__ float bf2f(unsigned short b) { return __builtin_bit_cast(float, (unsigned)b << 16); }
__device__ __forceinline__ float bflo(unsigned w) { return __builtin_bit_cast(float, w << 16); }
__device__ __forceinline__ float bfhi(unsigned w) { return __builtin_bit_cast(float, w & 0xffff0000u); }
__device__ __forceinline__ float wave_sum(float v) {
#pragma unroll
    for (int o = 1; o < 64; o <<= 1) v += __shfl_xor(v, o);
    return v;
}
__device__ __forceinline__ float wave_max(float v) {
#pragma unroll
    for (int o = 1; o < 64; o <<= 1) v = fmaxf(v, __shfl_xor(v, o));
    return v;
}

#define XB_TMO      128
#define XB_XCNT(j)  (256  + 64 * (j))
#define XB_XSUB(j)  (1280 + 64 * (j))
#define XB_XGEN(j)  (2304 + 64 * (j))
#define XB_TOP      3328
#define XB_TOPGEN   3392
#define XCD_BAR_WORDS 3456
#define XB_SPIN_CAP (1u << 18)

__device__ __forceinline__ unsigned xb_ld(unsigned* p)              { return __hip_atomic_load(p, __ATOMIC_RELAXED, __HIP_MEMORY_SCOPE_AGENT); }
__device__ __forceinline__ unsigned xb_add(unsigned* p, unsigned v) { return __hip_atomic_fetch_add(p, v, __ATOMIC_RELAXED, __HIP_MEMORY_SCOPE_AGENT); }
__device__ __forceinline__ unsigned xb_xcc_id() { return (unsigned)__builtin_amdgcn_s_getreg((3 << 11) | 20) & 0xFu; }
#define XB_SPIN(cond, bar) do { unsigned _sp = 0; while (cond) { __builtin_amdgcn_s_sleep(1); \
    if ((++_sp & 255u) == 0u) { if (xb_ld(&(bar)[XB_TMO])) break; if (_sp > XB_SPIN_CAP) { atomicAdd(&(bar)[XB_TMO], 1u); break; } } } } while (0)

struct XcdBarrier {
    unsigned* bar; unsigned x;
    volatile LAS unsigned* st;
};

__device__ __forceinline__ XcdBarrier xcd_barrier_post(unsigned* bar, volatile LAS unsigned* st) {
    XcdBarrier b; b.bar = bar; b.x = xb_xcc_id(); b.st = st;
    if (threadIdx.x == 0) (void)xb_add(&bar[XB_XCNT(b.x)], 1u);
    return b;
}
__device__ __forceinline__ void xcd_barrier_complete(unsigned* bar, unsigned x, unsigned& nloc, unsigned& nx) {
    const unsigned G = gridDim.x * gridDim.y * gridDim.z;
    unsigned sum, cnt, mine, sp = 0u;
    for (;;) {
        sum = 0u; cnt = 0u; mine = 0u;
#pragma unroll
        for (unsigned j = 0; j < 16; ++j) { const unsigned c = xb_ld(&bar[XB_XCNT(j)]); sum += c; cnt += (c > 0u) ? 1u : 0u; mine = (j == x) ? c : mine; }
        if (sum == G) break;
        __builtin_amdgcn_s_sleep(1);
        if ((++sp & 255u) == 0u) { if (xb_ld(&bar[XB_TMO])) break; if (sp > XB_SPIN_CAP) { atomicAdd(&bar[XB_TMO], 1u); break; } }
    }
    nloc = mine > 0u ? mine : 1u; nx = cnt > 0u ? cnt : 1u;
}

__device__ __forceinline__ void xcd_barrier(const XcdBarrier& b) {
    asm volatile("s_waitcnt vmcnt(0)" ::: "memory");
    __syncthreads();
    if (threadIdx.x == 0) {
        unsigned* bar = b.bar;
        __builtin_amdgcn_s_waitcnt(0);
        unsigned nloc = b.st[0], nx = b.st[1];
        if (nloc == 0u) { xcd_barrier_complete(bar, b.x, nloc, nx); b.st[0] = nloc; b.st[1] = nx; }
        const unsigned old = xb_add(&bar[XB_XSUB(b.x)], 1u);
        const unsigned gen = old / nloc;
        if (old + 1u == (gen + 1u) * nloc) {
            __builtin_amdgcn_fence(__ATOMIC_RELEASE, "agent");
            asm volatile("s_waitcnt vmcnt(0)" ::: "memory");
            const unsigned og = xb_add(&bar[XB_TOP], 1u);
            const unsigned tg = og / nx;
            if (og + 1u == (tg + 1u) * nx) xb_add(&bar[XB_TOPGEN], 1u);
            else XB_SPIN(xb_ld(&bar[XB_TOPGEN]) == tg, bar);
            __builtin_amdgcn_fence(__ATOMIC_ACQUIRE, "agent");
            xb_add(&bar[XB_XGEN(b.x)], 1u);
            asm volatile("s_waitcnt vmcnt(0)" ::: "memory");
        } else {
            XB_SPIN(xb_ld(&bar[XB_XGEN(b.x)]) == gen, bar);
            __builtin_amdgcn_fence(__ATOMIC_ACQUIRE, "agent");
            asm volatile("s_waitcnt vmcnt(0)" ::: "memory");
        }
    }
    __syncthreads();
}

typedef const __attribute__((address_space(4))) unsigned long long* KP;
struct Args { const float* in[18]; float* out; unsigned char* ws; int ph_lo, ph_hi; };

__device__ __forceinline__ void tr_item(const float* W, int ldw, int K, bf16_t* WT, int drow0, int scol0, int k0, LAS float* scr, int lane) {
#pragma unroll 8
    for (int i = 0; i < 32; ++i) { const int kk = 2 * i + (lane >> 5); scr[kk * 33 + (lane & 31)] = W[(size_t)(k0 + kk) * ldw + scol0 + (lane & 31)]; }
    asm volatile("s_waitcnt lgkmcnt(0)" ::: "memory");
    const int c = lane & 7;
#pragma unroll
    for (int j = 0; j < 4; ++j) { const int n = (lane >> 3) + 8 * j; const LAS float* s = scr + (8 * c) * 33 + n;
        v4u o; o.x = pk2(s[0 * 33], s[1 * 33]); o.y = pk2(s[2 * 33], s[3 * 33]); o.z = pk2(s[4 * 33], s[5 * 33]); o.w = pk2(s[6 * 33], s[7 * 33]);
        *(v4u*)(WT + (size_t)(drow0 + n) * K + k0 + 8 * c) = o; }
    asm volatile("s_waitcnt lgkmcnt(0)" ::: "memory");
}
__device__ __forceinline__ int abin_srccol(int d) {
    const int pn = d >> 8, jj = d & 255;
    if (pn <= 1 || pn == 4 || pn == 5) { const int bj = jj >> 7, r = jj & 127, hl = r >> 5, i = r & 31; const int head = 4 * (pn & 1) + hl; return (pn >= 4 ? 512 : 0) + 64 * head + 32 * bj + i; }
    if (pn == 2 || pn == 3) return 1536 + (d - 512);
    if (pn == 6 || pn == 7) return 1024 + (d - 1536);
    return d;
}
__device__ __forceinline__ void prologue(KP kp, LAS unsigned char* lds, int gw, int ngw, int wave) {
    int lane; { int l_ = threadIdx.x; asm volatile("" : "+v"(l_)); lane = l_ & 63; }
    LAS float* scr = (LAS float*)(lds + wave * 16384);
    unsigned char* ws = (unsigned char*)kp[19];
    constexpr int I_GU = 16 * 176, I_D = 44 * 32, I_ABI = 16 * 80, I_SQ = 16 * 32, I_CI = 16 * 96;
    constexpr int NITEMS = 4 * I_GU + 4 * I_D + I_ABI + I_SQ + I_CI + I_SQ;
    for (int it = gw; it < NITEMS; it += ngw) {
        int r = it;
        if (r < 4 * I_GU) { const int mi = r / I_GU, q = r % I_GU, kb = q / 176, nb = q % 176; const int d = nb * 32, pn = d >> 8, jj = d & 255;
            const int sc = (jj < 128) ? (128 * pn + jj) : (FF + 128 * pn + jj - 128);
            tr_item(((const float*)kp[3]) + (size_t)mi * D * 2 * FF, 2 * FF, D, (bf16_t*)(ws + WS_WGU) + (size_t)mi * 2 * FF * D, d, sc, kb * 64, scr, lane); continue; }
        r -= 4 * I_GU;
        if (r < 4 * I_D) { const int mi = r / I_D, q = r % I_D, kb = q / 32, nb = q % 32;
            tr_item(((const float*)kp[4]) + (size_t)mi * FF * D, D, FF, (bf16_t*)(ws + WS_WD) + (size_t)mi * D * FF, nb * 32, nb * 32, kb * 64, scr, lane); continue; }
        r -= 4 * I_D;
        if (r < I_ABI) { const int kb = r / 80, nb = r % 80; tr_item(((const float*)kp[5]), AB_IN, D, (bf16_t*)(ws + WS_WABI), nb * 32, abin_srccol(nb * 32), kb * 64, scr, lane); continue; }
        r -= I_ABI;
        if (r < I_SQ) { const int kb = r / 32, nb = r % 32; tr_item(((const float*)kp[10]), D, D, (bf16_t*)(ws + WS_WABO), nb * 32, nb * 32, kb * 64, scr, lane); continue; }
        r -= I_SQ;
        if (r < I_CI) { const int kb = r / 96, nb = r % 96; tr_item(((const float*)kp[11]), C_INW, D, (bf16_t*)(ws + WS_WCI), nb * 32, nb * 32, kb * 64, scr, lane); continue; }
        r -= I_CI;
        { const int kb = r / 32, nb = r % 32; tr_item(((const float*)kp[17]), D, D, (bf16_t*)(ws + WS_WCO), nb * 32, nb * 32, kb * 64, scr, lane); }
    }
    const int gt = gw * 64 + lane, ngt = ngw * 64;
    { const f32x4* x4 = (const f32x4*)((const float*)kp[0]); v4u* xb = (v4u*)(ws + WS_XB);
      for (int i = gt; i < T * D / 8; i += ngt) { const f32x4 p = x4[2 * i], q = x4[2 * i + 1]; v4u o; o.x = pk2(p.x, p.y); o.y = pk2(p.z, p.w); o.z = pk2(q.x, q.y); o.w = pk2(q.z, q.w); xb[i] = o; } }
    { float* wif = (float*)(ws + WS_WIF); for (int i = gt; i < 8 * D; i += ngt) { const int j = i >> 10, k = i & 1023; wif[i] = ((const float*)kp[11])[(size_t)k * C_INW + C_PROJ + j]; } }
    { float* rc = (float*)(ws + WS_ROPE); float* rs = rc + SEQ * 32;
      for (int i = gt; i < SEQ * 32; i += ngt) { const int pos = i >> 5, fi = i & 31;
          double inv = 1.0; const double r = 0.7498942093324559; for (int k = 0; k < fi; ++k) inv *= r;
          const float invf = (float)inv; const float angf = (float)pos * invf; const double ang = (double)angf;
          const double qd = rint(ang * 0.6366197723675814); const double s = fma(-qd, 1.5707963267948966, ang) - qd * 6.123233995736766e-17;
          const double s2 = s * s;
          const double sn = s * (1.0 + s2 * (-1.0 / 6 + s2 * (1.0 / 120 + s2 * (-1.0 / 5040 + s2 * (1.0 / 362880 + s2 * (-1.0 / 39916800))))));
          const double cs = 1.0 + s2 * (-0.5 + s2 * (1.0 / 24 + s2 * (-1.0 / 720 + s2 * (1.0 / 40320 + s2 * (-1.0 / 3628800 + s2 * (1.0 / 479001600))))));
          const int qi = ((int)qd) & 3; double c, sv;
          if (qi == 0) { c = cs; sv = sn; } else if (qi == 1) { c = -sn; sv = cs; } else if (qi == 2) { c = -cs; sv = -sn; } else { c = sn; sv = -cs; }
          rc[i] = (float)c; rs[i] = (float)sv; } }
}

__device__ __forceinline__ void ln_phase(const float* xin, const float* y, float ys, const float* g, const float* b, float* xout, bf16_t* xb,
                                         const float* wif, float* gates, const float* b_i, const float* b_f, LAS unsigned char* lds, int gw, int ngw) {
    LAS float* wl = (LAS float*)lds;
    int lane; { int l_ = threadIdx.x; asm volatile("" : "+v"(l_)); lane = l_ & 63; }
    if (wif) { for (int i = threadIdx.x; i < 8 * D / 4; i += NWAVES * 64) ((LAS f32x4*)wl)[i] = ((const f32x4*)wif)[i]; __syncthreads(); }
    f32x4 gv[4], bv[4];
#pragma unroll
    for (int j = 0; j < 4; ++j) { gv[j] = ((const f32x4*)g)[lane + 64 * j]; bv[j] = ((const f32x4*)b)[lane + 64 * j]; }
    for (int row = gw; row < T; row += ngw) {
        const f32x4* xr = (const f32x4*)(xin + (size_t)row * D) + lane; const f32x4* yr = (const f32x4*)(y + (size_t)row * D) + lane;
        f32x4 v[4]; float s = 0.f;
#pragma unroll
        for (int j = 0; j < 4; ++j) { const f32x4 xv = xr[64 * j], yv = yr[64 * j]; v[j] = xv * ALPHA + yv * ys; s += (v[j].x + v[j].y) + (v[j].z + v[j].w); }
        const float mean = wave_sum(s) * (1.f / D); float s2 = 0.f;
#pragma unroll
        for (int j = 0; j < 4; ++j) { v[j] = v[j] - mean; s2 += (v[j].x * v[j].x + v[j].y * v[j].y) + (v[j].z * v[j].z + v[j].w * v[j].w); }
        const float rstd = 1.f / sqrtf(wave_sum(s2) * (1.f / D) + LN_EPS);
#pragma unroll
        for (int j = 0; j < 4; ++j) v[j] = v[j] * rstd * gv[j] + bv[j];
        f32x4* xo = (f32x4*)(xout + (size_t)row * D) + lane;
#pragma unroll
        for (int j = 0; j < 4; ++j) xo[64 * j] = v[j];
        if (xb) { v2u* o8 = (v2u*)(xb + (size_t)row * D) + lane;
#pragma unroll
            for (int j = 0; j < 4; ++j) { v2u o; o.x = pk2(v[j].x, v[j].y); o.y = pk2(v[j].z, v[j].w); o8[64 * j] = o; } }
        if (wif) {
            float mine = 0.f;
#pragma unroll
            for (int q = 0; q < 8; ++q) { float p = 0.f;
#pragma unroll
                for (int j = 0; j < 4; ++j) { const f32x4 w = ((const LAS f32x4*)(wl + q * D))[lane + 64 * j]; p += (v[j].x * w.x + v[j].y * w.y) + (v[j].z * w.z + v[j].w * w.w); }
                p = wave_sum(p); if (lane == q) mine = p; }
            if (lane < 8) gates[(size_t)row * 8 + lane] = mine + (lane < 4 ? b_i[lane] : b_f[lane - 4]);
        }
    }
    if (wif) __syncthreads();
}
constexpr int PAB = AB_IN;
__device__ __forceinline__ void ab_stats_phase(const bf16_t* P, float* kmean, float* stats, int gw, int ngw) {
    int lane; { int l_ = threadIdx.x; asm volatile("" : "+v"(l_)); lane = l_ & 63; }
    const int r8 = lane >> 3, c8 = lane & 7;
    for (int it = gw; it < NB * 8 * 32; it += ngw) {
        const int b = it >> 8, h = (it >> 5) & 7, blk = it & 31;
        const bf16_t* kp = P + (size_t)(b * SEQ + blk * 256 + r8) * PAB + 1024 + h * 64 + c8 * 8;
        float s[8];
#pragma unroll
        for (int e = 0; e < 8; ++e) s[e] = 0.f;
#pragma unroll 4
        for (int i = 0; i < 32; ++i) { const v4u w = *(const v4u*)(kp + (size_t)(8 * i) * PAB);
            s[0] += bflo(w.x); s[1] += bfhi(w.x); s[2] += bflo(w.y); s[3] += bfhi(w.y); s[4] += bflo(w.z); s[5] += bfhi(w.z); s[6] += bflo(w.w); s[7] += bfhi(w.w); }
#pragma unroll
        for (int e = 0; e < 8; ++e) { s[e] += __shfl_xor(s[e], 8); s[e] += __shfl_xor(s[e], 16); s[e] += __shfl_xor(s[e], 32); }
        if (r8 == 0) { float* o = kmean + (size_t)it * 64 + c8 * 8;
#pragma unroll
            for (int e = 0; e < 8; ++e) o[e] = s[e] * (1.0f / 256.0f); }
    }
    for (int row = gw; row < T; row += ngw) {
        const v4u w = *(const v4u*)(P + (size_t)row * PAB + 2048 + lane * 8);
        float v[8] = { bflo(w.x), bfhi(w.x), bflo(w.y), bfhi(w.y), bflo(w.z), bfhi(w.z), bflo(w.w), bfhi(w.w) };
        float s = 0.f;
#pragma unroll
        for (int e = 0; e < 8; ++e) s += v[e];
        const float mean = wave_sum(s) * (1.0f / 512.0f); float q = 0.f;
#pragma unroll
        for (int e = 0; e < 8; ++e) { const float d = v[e] - mean; q += d * d; }
        const float rstd = 1.0f / sqrtf(wave_sum(q) * (1.0f / 512.0f) + LN_EPS);
        if (lane == 0) { stats[2 * row] = mean; stats[2 * row + 1] = rstd; }
    }
}
__device__ __forceinline__ void ab_select_phase(const bf16_t* P, const float* kmean, unsigned* sel, int gw, int ngw) {
    int lane; { int l_ = threadIdx.x; asm volatile("" : "+v"(l_)); lane = l_ & 63; }
    for (int it = gw; it < NB * 8 * 128; it += ngw) {
        const int b = it >> 10, h = (it >> 7) & 7, qc = it & 127, qblk = qc >> 2;
        const int tok = b * SEQ + qc * 64 + lane;
        unsigned mask = 0u;
        if (qblk > 0) {
            float q[64];
            const v4u* qp = (const v4u*)(P + (size_t)tok * PAB + h * 64);
#pragma unroll
            for (int j = 0; j < 8; ++j) { const v4u w = qp[j]; q[8 * j] = bflo(w.x); q[8 * j + 1] = bfhi(w.x); q[8 * j + 2] = bflo(w.y); q[8 * j + 3] = bfhi(w.y);
                q[8 * j + 4] = bflo(w.z); q[8 * j + 5] = bfhi(w.z); q[8 * j + 6] = bflo(w.w); q[8 * j + 7] = bfhi(w.w); }
            float v0 = -INFINITY, v1 = -INFINITY, v2 = -INFINITY; int i0 = -1, i1 = -1, i2 = -1;
            const float* km = kmean + (size_t)((b * 8 + h) * 32) * 64;
            for (int n = 0; n < qblk; ++n) {
                float g = 0.f;
#pragma unroll
                for (int d = 0; d < 64; ++d) g += q[d] * km[n * 64 + d];
                if (g > v0) { v2 = v1; i2 = i1; v1 = v0; i1 = i0; v0 = g; i0 = n; }
                else if (g > v1) { v2 = v1; i2 = i1; v1 = g; i1 = n; }
                else if (g > v2) { v2 = g; i2 = n; }
            }
            if (i0 >= 0) mask |= 1u << i0;
            if (i1 >= 0) mask |= 1u << i1;
            if (i2 >= 0) mask |= 1u << i2;
        }
        sel[(size_t)tok * 8 + h] = mask;
    }
}
__device__ __forceinline__ void sgu_phase(bf16_t* P, const float* stats, const float* lng, const float* lnb, const float* sw, const float* sb, LAS unsigned char* lds, int vcu, int G) {
    int tid_ = threadIdx.x; asm volatile("" : "+v"(tid_)); const int tid = tid_, lane = tid & 63, w = __builtin_amdgcn_readfirstlane(tid >> 6);
    LAS bf16_t* A = (LAS bf16_t*)lds;
    LAS bf16_t* Bt = (LAS bf16_t*)(lds + 128 * 136 * 2);
    const int fr = lane & 15, fq = lane >> 4;
    for (int it = vcu; it < 256 * 8; it += G) {
        const int ci = it >> 3, g = it & 7; const int tok0 = ci * 128;
        { const int t = tid >> 2, s0 = (tid & 3) * 32; const f32x4* wp = (const f32x4*)(sw + (size_t)(g * 128 + t) * 128 + s0);
#pragma unroll
          for (int j = 0; j < 4; ++j) { f32x4 p = wp[2 * j], q = wp[2 * j + 1]; const int s = s0 + 8 * j;
              v4u o; o.x = pk2(s <= t ? p.x : 0.f, s + 1 <= t ? p.y : 0.f); o.y = pk2(s + 2 <= t ? p.z : 0.f, s + 3 <= t ? p.w : 0.f);
              o.z = pk2(s + 4 <= t ? q.x : 0.f, s + 5 <= t ? q.y : 0.f); o.w = pk2(s + 6 <= t ? q.z : 0.f, s + 7 <= t ? q.w : 0.f);
              *(LAS v4u*)(A + t * 136 + s) = o; } }
        { const int s = tid >> 2, d0 = (tid & 3) * 16; const int tok = tok0 + s;
          const float mean = stats[2 * tok], rstd = stats[2 * tok + 1];
          const v4u* vp = (const v4u*)(P + (size_t)tok * PAB + 2048 + g * 64 + d0);
#pragma unroll
          for (int j = 0; j < 2; ++j) { const v4u wv = vp[j]; const float v[8] = { bflo(wv.x), bfhi(wv.x), bflo(wv.y), bfhi(wv.y), bflo(wv.z), bfhi(wv.z), bflo(wv.w), bfhi(wv.w) };
#pragma unroll
              for (int e = 0; e < 8; ++e) { const int d = d0 + 8 * j + e; const float vn = (v[e] - mean) * rstd * lng[g * 64 + d] + lnb[g * 64 + d];
                  Bt[d * 136 + s] = (bf16_t)f2bf(vn); } } }
        __syncthreads();
        f32x4 acc[4];
#pragma unroll
        for (int ct = 0; ct < 4; ++ct) acc[ct] = (f32x4){0.f, 0.f, 0.f, 0.f};
#pragma unroll
        for (int kk = 0; kk < 4; ++kk) {
            if (32 * kk <= 16 * w + 15) {
                const bf16x8 a = *(const LAS bf16x8*)(A + (16 * w + fr) * 136 + 32 * kk + 8 * fq);
#pragma unroll
                for (int ct = 0; ct < 4; ++ct) { const bf16x8 bb = *(const LAS bf16x8*)(Bt + (16 * ct + fr) * 136 + 32 * kk + 8 * fq);
                    acc[ct] = __builtin_amdgcn_mfma_f32_16x16x32_bf16(a, bb, acc[ct], 0, 0, 0); }
            }
        }
#pragma unroll
        for (int r = 0; r < 4; ++r) { const int t = 16 * w + 4 * fq + r; const float bias = sb[g * 128 + t];
#pragma unroll
            for (int ct = 0; ct < 4; ++ct) { bf16_t* up = P + (size_t)(tok0 + t) * PAB + 512 + g * 64 + 16 * ct + fr;
                const float u = bf2f(*up); *up = (bf16_t)f2bf(u * (acc[ct][r] + bias)); } }
        __syncthreads();
    }
}
constexpr int PC = C_PROJ;
__device__ __forceinline__ float wave_incl_sum(float v, int lane) {
#pragma unroll
    for (int o = 1; o < 64; o <<= 1) { const float t = __shfl_up(v, o); if (lane >= o) v += t; }
    return v;
}
__device__ __forceinline__ float wave_incl_max(float v, int lane) {
#pragma unroll
    for (int o = 1; o < 64; o <<= 1) { const float t = __shfl_up(v, o); if (lane >= o) v = fmaxf(v, t); }
    return v;
}
__device__ __forceinline__ float log_sigmoid(float f) { return fminf(f, 0.f) - log1pf(expf(-fabsf(f))); }
__device__ __forceinline__ void unpack8(const v4u w, float* x) { x[0] = bflo(w.x); x[1] = bfhi(w.x); x[2] = bflo(w.y); x[3] = bfhi(w.y); x[4] = bflo(w.z); x[5] = bfhi(w.z); x[6] = bflo(w.w); x[7] = bfhi(w.w); }
template <bool TRANS> __device__ __forceinline__ void stage_conv(LAS bf16_t* dst, int ld, const bf16_t* P, int tok0, int cseq, int colbase, const float* cw, const float* cb, float scale, int tid) {
    const int t = tid >> 3, cg = tid & 7; const int col = colbase + 16 * cg;
    float acc[16];
#pragma unroll
    for (int e = 0; e < 16; ++e) acc[e] = cb[col + e];
#pragma unroll
    for (int i = 0; i < 4; ++i) { const int tt = t - 3 + i;
        if (cseq > 0 || tt >= 0) { const v4u* xp = (const v4u*)(P + (size_t)(tok0 + tt) * PC + col); float x[16]; unpack8(xp[0], x); unpack8(xp[1], x + 8);
#pragma unroll
            for (int e = 0; e < 16; ++e) acc[e] += cw[i * 1024 + col + e] * x[e]; } }
#pragma unroll
    for (int e = 0; e < 16; ++e) { const float y = acc[e]; acc[e] = y * pg8::fast_sigmoid(y) * scale; }
    if (TRANS) {
#pragma unroll
        for (int e = 0; e < 16; ++e) dst[(16 * cg + e) * ld + t] = (bf16_t)f2bf(acc[e]);
    } else {
        v4u o0, o1; o0.x = pk2(acc[0], acc[1]); o0.y = pk2(acc[2], acc[3]); o0.z = pk2(acc[4], acc[5]); o0.w = pk2(acc[6], acc[7]);
        o1.x = pk2(acc[8], acc[9]); o1.y = pk2(acc[10], acc[11]); o1.z = pk2(acc[12], acc[13]); o1.w = pk2(acc[14], acc[15]);
        *(LAS v4u*)(dst + t * ld + 16 * cg) = o0; *(LAS v4u*)(dst + t * ld + 16 * cg + 8) = o1;
    }
}
__device__ __forceinline__ void stage_vt(LAS bf16_t* Vt, const bf16_t* P, int tok0, int colbase, const LAS float* wl, int tid) {
    const int s = tid >> 3, g = tid & 7; const v4u* vp = (const v4u*)(P + (size_t)(tok0 + s) * PC + colbase + 32 * g);
    const float w = wl ? wl[s] : 1.0f;
#pragma unroll
    for (int j = 0; j < 4; ++j) { float x[8]; unpack8(vp[j], x);
#pragma unroll
        for (int e = 0; e < 8; ++e) Vt[(32 * g + 8 * j + e) * 72 + s] = (bf16_t)f2bf(x[e] * w); }
}
__device__ __forceinline__ void mlstm_kv_phase(const bf16_t* P, const float* gates, const float* cw, const float* cb, bf16_t* state, float* bend, float* amax, float* ks,
                                               LAS unsigned char* lds, int vcu, int G) {
    const int w = __builtin_amdgcn_readfirstlane(threadIdx.x >> 6);
    LAS bf16_t* Kt = (LAS bf16_t*)lds;
    LAS bf16_t* Vt = (LAS bf16_t*)(lds + 18432);
    LAS float* wl = (LAS float*)(lds + 18432 + 36864);
    for (int it = vcu; it < 16 * 128; it += G) {
        int tid_ = threadIdx.x; asm volatile("" : "+v"(tid_)); const int tid = tid_, lane = tid & 63, fr = lane & 15, fq = lane >> 4;
        const int bh = it >> 7, c = it & 127, b = bh >> 2, h = bh & 3; const int tok0 = b * SEQ + c * 64;
        if (w == 0) {
            const float ig = gates[(size_t)(tok0 + lane) * 8 + h], fg = gates[(size_t)(tok0 + lane) * 8 + 4 + h];
            const float bb = wave_incl_sum(log_sigmoid(fg), lane);
            const float be = __shfl(bb, 63);
            const float a = be - bb + ig; const float am = wave_max(a);
            wl[lane] = expf(a - am);
            if (lane == 0) { bend[it] = be; amax[it] = am; }
        }
        stage_conv<true>(Kt, 72, P, tok0, c, 512 + h * 128, cw, cb, 0.08838834764831845f, tid);
        __syncthreads();
        stage_vt(Vt, P, tok0, 1024 + h * 256, wl, tid);
        if (tid < 128) { float s = 0.f;
#pragma unroll 8
            for (int j = 0; j < 64; ++j) s += bf2f(Kt[tid * 72 + j]) * wl[j];
            ks[(size_t)it * 128 + tid] = s; }
        __syncthreads();
        f32x4 acc[8][2];
#pragma unroll
        for (int mt = 0; mt < 8; ++mt) { acc[mt][0] = (f32x4){0.f, 0.f, 0.f, 0.f}; acc[mt][1] = (f32x4){0.f, 0.f, 0.f, 0.f}; }
#pragma unroll
        for (int kk = 0; kk < 2; ++kk) {
            const bf16x8 b0 = *(const LAS bf16x8*)(Vt + (32 * w + fr) * 72 + 32 * kk + 8 * fq), b1 = *(const LAS bf16x8*)(Vt + (32 * w + 16 + fr) * 72 + 32 * kk + 8 * fq);
#pragma unroll
            for (int mt = 0; mt < 8; ++mt) { const bf16x8 a = *(const LAS bf16x8*)(Kt + (16 * mt + fr) * 72 + 32 * kk + 8 * fq);
                acc[mt][0] = __builtin_amdgcn_mfma_f32_16x16x32_bf16(a, b0, acc[mt][0], 0, 0, 0); acc[mt][1] = __builtin_amdgcn_mfma_f32_16x16x32_bf16(a, b1, acc[mt][1], 0, 0, 0); }
        }
        bf16_t* st = state + (size_t)it * 32768;
#pragma unroll
        for (int mt = 0; mt < 8; ++mt)
#pragma unroll
            for (int nt = 0; nt < 2; ++nt) { const f32x4 v = acc[mt][nt]; v2u o; o.x = pk2(v[0], v[1]); o.y = pk2(v[2], v[3]);
                *(v2u*)(st + (size_t)(32 * w + 16 * nt + fr) * 128 + 16 * mt + 4 * fq) = o; }
        __syncthreads();
    }
}
__device__ __forceinline__ void mlstm_scan_phase(bf16_t* state, const float* bend, const float* amax, const float* ks, float* nin, float* min_) {
    int tid_ = threadIdx.x; asm volatile("" : "+v"(tid_)); const int tid = tid_;
    const int bx = blockIdx.x; const int bh = bx >> 4; const bool nscan = ((bx & 15) == 0) && tid < 128;
    bf16_t* sp = state + (size_t)bh * 128 * 32768 + (size_t)((bx & 15) * 512 + tid) * 4;
    float C0 = 0.f, C1 = 0.f, C2 = 0.f, C3 = 0.f, n = 0.f, m = 0.f;
    for (int c0 = 0; c0 < 128; c0 += 8) {
        v2u kv[8];
#pragma unroll
        for (int j = 0; j < 8; ++j) kv[j] = *(const v2u*)(sp + (size_t)(c0 + j) * 32768);
#pragma unroll
        for (int j = 0; j < 8; ++j) { const int c = c0 + j;
            const float be = bend[bh * 128 + c], am = amax[bh * 128 + c];
            const float mn = fmaxf(be + m, am); const float dec = expf(be + m - mn), inj = expf(am - mn);
            v2u o; o.x = pk2(C0, C1); o.y = pk2(C2, C3); *(v2u*)(sp + (size_t)c * 32768) = o;
            C0 = dec * C0 + inj * bflo(kv[j].x); C1 = dec * C1 + inj * bfhi(kv[j].x); C2 = dec * C2 + inj * bflo(kv[j].y); C3 = dec * C3 + inj * bfhi(kv[j].y);
            if (nscan) { nin[(size_t)(bh * 128 + c) * 128 + tid] = n; n = dec * n + inj * ks[(size_t)(bh * 128 + c) * 128 + tid]; if (tid == 0) min_[bh * 128 + c] = m; }
            m = mn; }
    }
}
__device__ __forceinline__ void mlstm_out_phase(const bf16_t* P, const float* gates, const float* cw, const float* cb, const bf16_t* state, const float* nin, const float* min_,
                                                const float* headg, bf16_t* mix, LAS unsigned char* lds, int vcu, int G) {
    const int w = __builtin_amdgcn_readfirstlane(threadIdx.x >> 6);
    LAS bf16_t* Qs = (LAS bf16_t*)lds;
    LAS bf16_t* Ks = (LAS bf16_t*)(lds + 17408);
    LAS bf16_t* Vt = (LAS bf16_t*)(lds + 34816);
    LAS bf16_t* Ps = (LAS bf16_t*)(lds + 71680);
    LAS float* fl = (LAS float*)(lds + 80896);
    LAS float* bv = fl, *ibv = fl + 64, *mtv = fl + 128, *itv = fl + 192, *dp0 = fl + 256, *dp1 = fl + 320, *d2v = fl + 384, *unused_ = fl + 448; (void)unused_;
    LAS float* Hs = (LAS float*)lds;
    for (int it = vcu; it < 16 * 128; it += G) {
        int tid_ = threadIdx.x; asm volatile("" : "+v"(tid_)); const int tid = tid_, lane = tid & 63, fr = lane & 15, fq = lane >> 4;
        const int bh = it >> 7, c = it & 127, b = bh >> 2, h = bh & 3; const int tok0 = b * SEQ + c * 64;
        if (w == 0) {
            const float ig = gates[(size_t)(tok0 + lane) * 8 + h], fg = gates[(size_t)(tok0 + lane) * 8 + 4 + h];
            const float bb = wave_incl_sum(log_sigmoid(fg), lane);
            const float ib = ig - bb; const float cm = wave_incl_max(ib, lane);
            const float mi = min_[it]; const float mt = bb + fmaxf(mi, cm);
            bv[lane] = bb; ibv[lane] = ib; mtv[lane] = mt; itv[lane] = expf(bb + mi - mt);
        }
        stage_conv<false>(Qs, 136, P, tok0, c, h * 128, cw, cb, 1.0f, tid);
        stage_conv<false>(Ks, 136, P, tok0, c, 512 + h * 128, cw, cb, 0.08838834764831845f, tid);
        stage_vt(Vt, P, tok0, 1024 + h * 256, nullptr, tid);
        __syncthreads();
        {
            const int rt = w >> 1, ch = w & 1;
            f32x4 sa[2] = { (f32x4){0.f, 0.f, 0.f, 0.f}, (f32x4){0.f, 0.f, 0.f, 0.f} };
#pragma unroll
            for (int kk = 0; kk < 4; ++kk) { const bf16x8 a = *(const LAS bf16x8*)(Qs + (16 * rt + fr) * 136 + 32 * kk + 8 * fq);
#pragma unroll
                for (int j = 0; j < 2; ++j) { const bf16x8 bb = *(const LAS bf16x8*)(Ks + (16 * (2 * ch + j) + fr) * 136 + 32 * kk + 8 * fq);
                    sa[j] = __builtin_amdgcn_mfma_f32_16x16x32_bf16(a, bb, sa[j], 0, 0, 0); } }
#pragma unroll
            for (int r = 0; r < 4; ++r) { const int t = 16 * rt + 4 * fq + r; const float bt = bv[t] - mtv[t]; float rs = 0.f;
#pragma unroll
                for (int j = 0; j < 2; ++j) { const int s = 16 * (2 * ch + j) + fr; const float p = (s <= t) ? sa[j][r] * expf(bt + ibv[s]) : 0.f; rs += p; Ps[t * 72 + s] = (bf16_t)f2bf(p); }
                rs += __shfl_xor(rs, 1); rs += __shfl_xor(rs, 2); rs += __shfl_xor(rs, 4); rs += __shfl_xor(rs, 8);
                if (fr == 0) { if (ch == 0) dp0[t] = rs; else dp1[t] = rs; } }
        }
        if (w == 7) { float s = 0.f; const float* np = nin + (size_t)it * 128;
#pragma unroll 8
            for (int k = 0; k < 128; ++k) s += bf2f(Qs[lane * 136 + k]) * np[k];
            d2v[lane] = s; }
        __syncthreads();
        f32x4 a1[4][2], a2[4][2];
#pragma unroll
        for (int rt = 0; rt < 4; ++rt)
#pragma unroll
            for (int ct = 0; ct < 2; ++ct) { a1[rt][ct] = (f32x4){0.f, 0.f, 0.f, 0.f}; a2[rt][ct] = (f32x4){0.f, 0.f, 0.f, 0.f}; }
#pragma unroll
        for (int kk = 0; kk < 2; ++kk) {
            const bf16x8 b0 = *(const LAS bf16x8*)(Vt + (32 * w + fr) * 72 + 32 * kk + 8 * fq), b1 = *(const LAS bf16x8*)(Vt + (32 * w + 16 + fr) * 72 + 32 * kk + 8 * fq);
#pragma unroll
            for (int rt = 0; rt < 4; ++rt) { const bf16x8 a = *(const LAS bf16x8*)(Ps + (16 * rt + fr) * 72 + 32 * kk + 8 * fq);
                a1[rt][0] = __builtin_amdgcn_mfma_f32_16x16x32_bf16(a, b0, a1[rt][0], 0, 0, 0); a1[rt][1] = __builtin_amdgcn_mfma_f32_16x16x32_bf16(a, b1, a1[rt][1], 0, 0, 0); }
        }
        const bf16_t* st = state + (size_t)it * 32768;
#pragma unroll
        for (int kk = 0; kk < 4; ++kk) {
            const bf16x8 b0 = *(const bf16x8*)(st + (size_t)(32 * w + fr) * 128 + 32 * kk + 8 * fq), b1 = *(const bf16x8*)(st + (size_t)(32 * w + 16 + fr) * 128 + 32 * kk + 8 * fq);
#pragma unroll
            for (int rt = 0; rt < 4; ++rt) { const bf16x8 a = *(const LAS bf16x8*)(Qs + (16 * rt + fr) * 136 + 32 * kk + 8 * fq);
                a2[rt][0] = __builtin_amdgcn_mfma_f32_16x16x32_bf16(a, b0, a2[rt][0], 0, 0, 0); a2[rt][1] = __builtin_amdgcn_mfma_f32_16x16x32_bf16(a, b1, a2[rt][1], 0, 0, 0); }
        }
        __syncthreads();
#pragma unroll
        for (int rt = 0; rt < 4; ++rt)
#pragma unroll
            for (int r = 0; r < 4; ++r) { const int t = 16 * rt + 4 * fq + r; const float inter = itv[t];
                const float den = dp0[t] + dp1[t] + inter * d2v[t]; const float rd = 1.0f / fmaxf(fabsf(den), expf(-mtv[t]));
                Hs[t * 260 + 32 * w + fr] = (a1[rt][0][r] + inter * a2[rt][0][r]) * rd;
                Hs[t * 260 + 32 * w + 16 + fr] = (a1[rt][1][r] + inter * a2[rt][1][r]) * rd; }
        __syncthreads();
        { const f32x4 hg = *(const f32x4*)(headg + h * 256 + 4 * lane);
#pragma unroll 1
          for (int i = 0; i < 8; ++i) { const int t = 8 * w + i; const f32x4 v = *(const LAS f32x4*)(Hs + t * 260 + 4 * lane);
              const float mu = wave_sum((v.x + v.y) + (v.z + v.w)) * (1.0f / 256.0f);
              const f32x4 d = v - mu; const float var = wave_sum((d.x * d.x + d.y * d.y) + (d.z * d.z + d.w * d.w)) * (1.0f / 256.0f);
              const float rstd = 1.0f / sqrtf(var + LN_EPS); const size_t tok = (size_t)(tok0 + t);
              const v2u ow = *(const v2u*)(P + tok * PC + 2048 + h * 256 + 4 * lane);
              v2u o; o.x = pk2(d.x * rstd * hg.x * pg8::fast_sigmoid(bflo(ow.x)), d.y * rstd * hg.y * pg8::fast_sigmoid(bfhi(ow.x)));
              o.y = pk2(d.z * rstd * hg.z * pg8::fast_sigmoid(bflo(ow.y)), d.w * rstd * hg.w * pg8::fast_sigmoid(bfhi(ow.y)));
              *(v2u*)(mix + tok * D + h * 256 + 4 * lane) = o; } }
        __syncthreads();
    }
}
#define MIXER_AB \
    PHASE({ pg8::Gemm g{XB, (const bf16_t*)(ws + WS_WABI), T, AB_IN, D, D}; pg8::StaticOrder S; S.init(T, AB_IN, G, bx); \
            pg8::EpiAB E{BIG, AB_IN, (const float*)(ws + WS_ROPE), (const float*)(ws + WS_ROPE) + SEQ * 32, attn_body::C2}; \
            pg8::gemm_phase<pg8::EpiAB, pg8::StaticOrder, true, true>(lds, g, S, E); }); \
    PHASE(ab_stats_phase(BIG, (float*)(ws + WS_KMEAN), (float*)(ws + WS_STATS), gw, ngw)); \
    PHASE(ab_select_phase(BIG, (const float*)(ws + WS_KMEAN), (unsigned*)(ws + WS_SEL), gw, ngw)); \
    PHASE({ const attn_body::AttnTensors AT{(const attn_body::bf16*)BIG, (const attn_body::bf16*)(BIG + 1024), (const attn_body::bf16*)(BIG + 1536), (attn_body::bf16*)BIG, (const unsigned*)(ws + WS_SEL)}; \
            const attn_body::StaticOrder S(G, bx); attn_body::attn_phase<attn_body::StaticOrder>((char*)lds_raw, AT, S); \
            sgu_phase(BIG, (const float*)(ws + WS_STATS), IN(6), IN(7), IN(8), IN(9), lds, vcu, G); }); \
    PHASE({ pg8::Gemm g{BIG, (const bf16_t*)(ws + WS_WABO), T, D, D, AB_IN}; pg8::StaticOrder S; S.init(T, D, G, bx); \
            pg8::EpiF32 E{Y, D}; pg8::gemm_phase<pg8::EpiF32, pg8::StaticOrder, true, true>(lds, g, S, E); });
#define MIXER_C \
    PHASE({ pg8::Gemm g{XB, (const bf16_t*)(ws + WS_WCI), T, C_PROJ, D, D}; pg8::StaticOrder S; S.init(T, C_PROJ, G, bx); \
            pg8::EpiBf16Plain E{BIG, C_PROJ}; pg8::gemm_phase<pg8::EpiBf16Plain, pg8::StaticOrder, true, true>(lds, g, S, E); }); \
    PHASE(mlstm_kv_phase(BIG, (const float*)(ws + WS_GATES), IN(12), IN(13), (bf16_t*)Y, (float*)(ws + WS_BEND), (float*)(ws + WS_AMAX), (float*)(ws + WS_KS), lds, vcu, G)); \
    PHASE(mlstm_scan_phase((bf16_t*)Y, (const float*)(ws + WS_BEND), (const float*)(ws + WS_AMAX), (const float*)(ws + WS_KS), (float*)(ws + WS_NIN), (float*)(ws + WS_MIN))); \
    PHASE(mlstm_out_phase(BIG, (const float*)(ws + WS_GATES), IN(12), IN(13), (const bf16_t*)Y, (const float*)(ws + WS_NIN), (const float*)(ws + WS_MIN), IN(16), XB, lds, vcu, G)); \
    PHASE({ pg8::Gemm g{XB, (const bf16_t*)(ws + WS_WCO), T, D, D, D}; pg8::StaticOrder S; S.init(T, D, G, bx); \
            pg8::EpiF32 E{Y, D}; pg8::gemm_phase<pg8::EpiF32, pg8::StaticOrder, true, true>(lds, g, S, E); });
#define MIXER_C_YS 1.0f
__global__ void __launch_bounds__(NWAVES * 64, 2) mk_fwd(Args args) {
    extern __shared__ __attribute__((aligned(16))) unsigned char lds_raw[];
    LAS unsigned char* lds = (LAS unsigned char*)lds_raw;
    { cg::grid_group grid = cg::this_grid(); if (args.ph_hi - args.ph_lo > 1) grid.sync(); }
    if (threadIdx.x < 8) ((LAS unsigned*)(lds + LDS_MISC))[threadIdx.x] = 0u;
    __syncthreads();
    XcdBarrier bar = xcd_barrier_post((unsigned*)args.ws, (volatile LAS unsigned*)(lds + LDS_MISC));
    const int wave = __builtin_amdgcn_readfirstlane(threadIdx.x >> 6);
    const int G = gridDim.x, bx = blockIdx.x;
    const int vcu = (G % 8 == 0) ? (bx % 8) * (G / 8) + bx / 8 : bx;
    const int gw = vcu * NWAVES + wave, ngw = G * NWAVES;
    const int lo = args.ph_lo, hi = args.ph_hi; int ph = 0;
#define PHASE(...) do { if (ph >= lo && ph < hi) { KP kp = (KP)__builtin_amdgcn_kernarg_segment_ptr(); asm volatile("" : "+s"(kp)); \
        unsigned char* ws = (unsigned char*)kp[19]; bf16_t* XB = (bf16_t*)(ws + WS_XB); bf16_t* BIG = (bf16_t*)(ws + WS_BIG); float* Y = (float*)(ws + WS_Y); float* XF = (float*)kp[18]; \
        const float* lng = (const float*)kp[1]; const float* lnb = (const float*)kp[2]; (void)XB; (void)BIG; (void)Y; (void)XF; (void)lng; (void)lnb; \
        __VA_ARGS__; if (ph + 1 < hi) xcd_barrier(bar); } ++ph; } while (0)
#define IN(i) ((const float*)kp[i])

    PHASE(prologue(kp, lds, gw, ngw, wave));

#define LN_MIX(l, ys) PHASE(ln_phase(XF, Y, ys, lng + ((l) * 3 + 1) * D, lnb + ((l) * 3 + 1) * D, XF, XB, nullptr, nullptr, nullptr, nullptr, lds, gw, ngw))
#define FFN_HALF(l, half) do { const int wi = (l) * 2 + (half); \
            PHASE({ pg8::Gemm g{XB, (const bf16_t*)(ws + WS_WGU) + (size_t)wi * 2 * FF * D, T, 2 * FF, D, D}; pg8::StaticOrder S; S.init(T, 2 * FF, G, bx); \
                    pg8::EpiSwiGLU E{BIG, FF}; pg8::gemm_phase<pg8::EpiSwiGLU, pg8::StaticOrder, true, true>(lds, g, S, E); }); \
            PHASE({ pg8::Gemm g{BIG, (const bf16_t*)(ws + WS_WD) + (size_t)wi * D * FF, T, D, FF, FF}; pg8::StaticOrder S; S.init(T, D, G, bx); \
                    pg8::EpiF32 E{Y, D}; pg8::gemm_phase<pg8::EpiF32, pg8::StaticOrder, true, true>(lds, g, S, E); }); \
            const int li = (l) * 3 + ((half) == 0 ? 0 : 2); \
            const bool first = ((l) == 0 && (half) == 0), gates = ((l) == 1 && (half) == 0), last = ((l) == 1 && (half) == 1); \
            PHASE(ln_phase(first ? IN(0) : XF, Y, 0.5f, lng + li * D, lnb + li * D, XF, last ? nullptr : XB, \
                           gates ? (const float*)(ws + WS_WIF) : nullptr, (float*)(ws + WS_GATES), IN(14), IN(15), lds, gw, ngw)); } while (0)
    FFN_HALF(0, 0);
    MIXER_AB
    LN_MIX(0, 1.0f);
    FFN_HALF(0, 1);
    FFN_HALF(1, 0);
    MIXER_C
    LN_MIX(1, MIXER_C_YS);
    FFN_HALF(1, 1);
#undef PHASE
}

extern "C" void kernel_launch(void* const* d_in, const int* in_sizes, int n_in, void* d_out, int out_size, void* d_ws, size_t ws_size, hipStream_t stream) {
    static int grid = 0;
    if (grid == 0) {
        if (n_in != 18 || in_sizes[0] != T * D || out_size != T * D || ws_size < WS_END) { fprintf(stderr, "kernel_launch: unexpected shapes (n_in %d, in0 %d, out %d, ws %zu)\n", n_in, n_in > 0 ? in_sizes[0] : -1, out_size, ws_size); grid = -1; return; }
        int dev = 0, cus = 0, per_cu = 0;
        (void)hipGetDevice(&dev); (void)hipDeviceGetAttribute(&cus, hipDeviceAttributeMultiprocessorCount, dev);
        if (hipFuncSetAttribute((const void*)mk_fwd, hipFuncAttributeMaxDynamicSharedMemorySize, LDS_BYTES) != hipSuccess) { fprintf(stderr, "kernel_launch: hipFuncSetAttribute failed\n"); grid = -1; return; }
        (void)hipOccupancyMaxActiveBlocksPerMultiprocessor(&per_cu, (const void*)mk_fwd, NWAVES * 64, LDS_BYTES);
        (void)hipGetLastError();
        if (per_cu < 1) per_cu = 1;
        grid = cus;
        fprintf(stderr, "kernel_launch: cus %d per_cu %d grid %d\n", cus, per_cu, grid);
    }
    if (grid < 0) return;
    if (hipMemsetAsync(d_ws, 0, 65536, stream) != hipSuccess) { fprintf(stderr, "kernel_launch: memset failed\n"); return; }
    Args a{};
    for (int i = 0; i < 18; ++i) a.in[i] = (const float*)d_in[i];
    a.out = (float*)d_out; a.ws = (unsigned char*)d_ws;
#if MK_MULTI
    for (int p = 0; p < MK_NPHASES; ++p) { a.ph_lo = p; a.ph_hi = p + 1; hipLaunchKernelGGL(mk_fwd, dim3(grid), dim3(NWAVES * 64), LDS_BYTES, stream, a); }
#else
    a.ph_lo = 0; a.ph_hi = 1 << 20;
    void* kargs[] = { &a };
    hipError_t e = hipLaunchCooperativeKernel((const void*)mk_fwd, dim3(grid), dim3(NWAVES * 64), kargs, LDS_BYTES, stream);
    if (e != hipSuccess) fprintf(stderr, "kernel_launch: cooperative launch failed: %s (grid %d)\n", hipGetErrorString(e), grid);
#endif
}
```

```cpp
#include <hip/hip_runtime.h>
#include <hip/hip_cooperative_groups.h>
#include <hip/hip_bf16.h>
#include <cstdio>
#include <cstdint>
#include <cmath>
namespace cg = cooperative_groups;
#ifndef MK_MULTI
#define MK_MULTI 0
#endif
#define MK_NPHASES 64
namespace pg8 {
#define PG8_LAS __attribute__((address_space(3)))
typedef unsigned short bf16_t;
typedef short bf16x8 __attribute__((ext_vector_type(8)));
typedef float f32x4 __attribute__((ext_vector_type(4)));
typedef unsigned u32x4 __attribute__((ext_vector_type(4)));
constexpr int BM = 256, BK = 64, HALF = 128, HTB = HALF * BK * 2  , STAGE_BYTES = 8 * HTB, NXCD = 8, WGM = 8;

__host__ __device__ __forceinline__ int lds_byte(int r, int c) { const int st = (r >> 4) * 2 + (c >> 5), rr = r & 15, cc = c & 31, ob = rr * 64 + cc * 2; return st * 1024 + (ob ^ (((ob >> 9) & 1) << 5)); }
__host__ __device__ __forceinline__ void stage_rc(int b, int& R, int& C) { const int st = b / 1024, sb = b % 1024, swz = sb ^ (((sb >> 9) & 1) << 5); R = (st >> 1) * 16 + swz / 64; C = (st & 1) * 32 + (swz % 64) / 2; }
__host__ __device__ __forceinline__ int perm32(int rho) { const int n = rho >> 4, i = rho & 15; return 8 * (i >> 2) + 4 * n + (i & 3); }

struct Unit { int pm, pn; };
struct Gemm { const bf16_t* A; const bf16_t* Bt; int M, N, K, lda; };

struct StaticOrder {
    int nM, nN, nwg, G, c;
    __host__ __device__ void init(int M, int N, int G_, int c_) { nM = M / BM; nN = N / BM; nwg = nM * nN; G = G_; c = c_; }
    __host__ __device__ bool next(int i, Unit& u) const {
        const long L = (long)i * G + c; if (L >= nwg) return false;
        int wgid = (int)L; { const int q = nwg / NXCD, r = nwg % NXCD, xcd = wgid % NXCD, off = wgid / NXCD; wgid = (xcd < r ? xcd * (q + 1) : r * (q + 1) + (xcd - r) * q) + off; }
        const int nig = WGM * nN, gid = wgid / nig, fm = gid * WGM, gsz = (nM - fm) < WGM ? (nM - fm) : WGM;
        u.pm = fm + ((wgid % nig) % gsz); u.pn = (wgid % nig) / gsz; return true;
    }
    __device__ __forceinline__ void a_ready(const Unit&) const {}
    __device__ __forceinline__ void done(const Unit&) const {}
};

__device__ __forceinline__ unsigned cvt_pk_bf16(float lo, float hi) { unsigned r; asm volatile("v_cvt_pk_bf16_f32 %0, %1, %2" : "=v"(r) : "v"(lo), "v"(hi)); return r; }
typedef float f32x2 __attribute__((ext_vector_type(2)));
__device__ __forceinline__ float fast_sigmoid(float x) { return __builtin_amdgcn_rcpf(1.0f + __expf(-x)); }
__device__ __forceinline__ float gelu_tanh(float x) {
    const float u = 1.5957691216057308f * (x + 0.044715f * x * x * x);
    return x * fast_sigmoid(u);
}
struct EpiSwiGLU {
    static constexpr bool PERM = true, AFTER_DRAIN = false;
    bf16_t* H; int ldh;
    __device__ __forceinline__ void operator()(const f32x4 (&acc)[2][2][4][2], const Unit& u, int wr, int wc, int fr, int fq) const {
        const int row0 = u.pm * BM + wr * 64 + fr, col0 = u.pn * HALF + wc * 32 + 8 * fq;
#pragma unroll
        for (int ai = 0; ai < 2; ++ai)
#pragma unroll
            for (int m = 0; m < 4; ++m) {
                bf16_t* rowp = H + (size_t)(row0 + ai * HALF + m * 16) * ldh + col0;
                float h[8];
#pragma unroll
                for (int n = 0; n < 2; ++n)
#pragma unroll
                    for (int e = 0; e < 4; ++e) { const float g = acc[ai][0][m][n][e], uu = acc[ai][1][m][n][e]; h[4 * n + e] = g * fast_sigmoid(g) * uu; }
                u32x4 w; w.x = cvt_pk_bf16(h[0], h[1]); w.y = cvt_pk_bf16(h[2], h[3]); w.z = cvt_pk_bf16(h[4], h[5]); w.w = cvt_pk_bf16(h[6], h[7]);
                *(u32x4*)rowp = w;
            }
    }
};
struct EpiF32 {
    static constexpr bool PERM = false, AFTER_DRAIN = false;
    float* Y; int ldc;
    __device__ __forceinline__ void operator()(const f32x4 (&acc)[2][2][4][2], const Unit& u, int wr, int wc, int fr, int fq) const {
        const int row0 = u.pm * BM + wr * 64 + fr, col0 = u.pn * BM + wc * 32 + 4 * fq;
#pragma unroll
        for (int ai = 0; ai < 2; ++ai)
#pragma unroll
            for (int m = 0; m < 4; ++m) {
                float* rowp = Y + (size_t)(row0 + ai * HALF + m * 16) * ldc + col0;
#pragma unroll
                for (int bj = 0; bj < 2; ++bj)
#pragma unroll
                    for (int n = 0; n < 2; ++n) *(f32x4*)(rowp + bj * HALF + n * 16) = acc[ai][bj][m][n];
            }
    }
};
struct EpiBf16Plain {
    static constexpr bool PERM = true, AFTER_DRAIN = false;
    bf16_t* O; int ldc;
    __device__ __forceinline__ void operator()(const f32x4 (&acc)[2][2][4][2], const Unit& u, int wr, int wc, int fr, int fq) const {
        const int row0 = u.pm * BM + wr * 64 + fr, col0 = u.pn * BM + wc * 32 + 8 * fq;
#pragma unroll
        for (int ai = 0; ai < 2; ++ai)
#pragma unroll
            for (int m = 0; m < 4; ++m) {
                bf16_t* rowp = O + (size_t)(row0 + ai * HALF + m * 16) * ldc + col0;
#pragma unroll
                for (int bj = 0; bj < 2; ++bj) { const f32x4 v0 = acc[ai][bj][m][0], v1 = acc[ai][bj][m][1];
                    u32x4 w; w.x = cvt_pk_bf16(v0[0], v0[1]); w.y = cvt_pk_bf16(v0[2], v0[3]); w.z = cvt_pk_bf16(v1[0], v1[1]); w.w = cvt_pk_bf16(v1[2], v1[3]);
                    *(u32x4*)(rowp + bj * HALF) = w; }
            }
    }
};
struct EpiAB {
    static constexpr bool PERM = true, AFTER_DRAIN = false;
    bf16_t* O; int ldc; const float* rcos; const float* rsin; float qscale;
    __device__ __forceinline__ void operator()(const f32x4 (&acc)[2][2][4][2], const Unit& u, int wr, int wc, int fr, int fq) const {
        const int row0 = u.pm * BM + wr * 64 + fr;
        const int kind = (u.pn == 0 || u.pn == 1) ? 0 : (u.pn == 4 || u.pn == 5) ? 1 : (u.pn == 6 || u.pn == 7) ? 2 : 3;
        if (kind <= 1) {
            const float sc = kind == 0 ? qscale : 1.0f;
            const int colb = u.pn * BM + wc * 64 + 8 * fq;
#pragma unroll
            for (int ai = 0; ai < 2; ++ai)
#pragma unroll
                for (int m = 0; m < 4; ++m) {
                    const int row = row0 + ai * HALF + m * 16; const int pos = row & 8191;
                    const f32x4 c0 = *(const f32x4*)(rcos + pos * 32 + 8 * fq), c1 = *(const f32x4*)(rcos + pos * 32 + 8 * fq + 4);
                    const f32x4 s0 = *(const f32x4*)(rsin + pos * 32 + 8 * fq), s1 = *(const f32x4*)(rsin + pos * 32 + 8 * fq + 4);
                    float o1[8], o2[8];
#pragma unroll
                    for (int e = 0; e < 4; ++e) {
                        const float a1 = acc[ai][0][m][0][e], a2 = acc[ai][1][m][0][e], b1 = acc[ai][0][m][1][e], b2 = acc[ai][1][m][1][e];
                        o1[e] = (a1 * c0[e] - a2 * s0[e]) * sc; o2[e] = (a2 * c0[e] + a1 * s0[e]) * sc;
                        o1[4 + e] = (b1 * c1[e] - b2 * s1[e]) * sc; o2[4 + e] = (b2 * c1[e] + b1 * s1[e]) * sc;
                    }
                    bf16_t* rowp = O + (size_t)row * ldc + colb;
                    u32x4 w; w.x = cvt_pk_bf16(o1[0], o1[1]); w.y = cvt_pk_bf16(o1[2], o1[3]); w.z = cvt_pk_bf16(o1[4], o1[5]); w.w = cvt_pk_bf16(o1[6], o1[7]);
                    *(u32x4*)rowp = w;
                    w.x = cvt_pk_bf16(o2[0], o2[1]); w.y = cvt_pk_bf16(o2[2], o2[3]); w.z = cvt_pk_bf16(o2[4], o2[5]); w.w = cvt_pk_bf16(o2[6], o2[7]);
                    *(u32x4*)(rowp + 32) = w;
                }
        } else {
            const int col0 = u.pn * BM + wc * 32 + 8 * fq;
#pragma unroll
            for (int ai = 0; ai < 2; ++ai)
#pragma unroll
                for (int m = 0; m < 4; ++m) {
                    bf16_t* rowp = O + (size_t)(row0 + ai * HALF + m * 16) * ldc + col0;
#pragma unroll
                    for (int bj = 0; bj < 2; ++bj) { f32x4 v0 = acc[ai][bj][m][0], v1 = acc[ai][bj][m][1];
                        if (kind == 3) {
#pragma unroll
                            for (int e = 0; e < 4; ++e) { v0[e] = gelu_tanh(v0[e]); v1[e] = gelu_tanh(v1[e]); } }
                        u32x4 w; w.x = cvt_pk_bf16(v0[0], v0[1]); w.y = cvt_pk_bf16(v0[2], v0[3]); w.z = cvt_pk_bf16(v1[0], v1[1]); w.w = cvt_pk_bf16(v1[2], v1[3]);
                        *(u32x4*)(rowp + bj * HALF) = w; }
                }
        }
    }
};
template <class Epi, class Sched, bool ALIGN_EPI = false, bool SP2 = false>
__device__ __forceinline__ void gemm_phase(PG8_LAS unsigned char* lds, const Gemm g, const Sched& S, const Epi& E) {
    int tid_ = threadIdx.x; asm volatile("" : "+v"(tid_)); const int tid = tid_, wid = __builtin_amdgcn_readfirstlane(tid >> 6), lane = tid & 63, wr = wid >> 2, wc = wid & 3, fr = lane & 15, fq = lane >> 4;
    const int K = g.K, nt = K / BK;
    unsigned voffA[2], voffB[2];
#pragma unroll
    for (int i = 0; i < 2; ++i) { int R, C; stage_rc(tid * 16 + i * 8192, R, C); const int Rb = Epi::PERM ? ((R & ~31) + perm32(R & 31)) : R;
        voffA[i] = (unsigned)(R * g.lda + C) * 2u; voffB[i] = (unsigned)(Rb * K + C) * 2u; }
    const size_t kstep = (size_t)(BK * 2);
    const size_t hstep = (size_t)HALF * K * 2;
    const size_t tstep = 2 * hstep; const size_t hstepA = (size_t)HALF * g.lda * 2, tstepA = 2 * hstepA;
    const unsigned ldsw = (unsigned)wid * 1024u;
    const int aoff = lds_byte(wr * 64 + fr, fq * 8), boff = lds_byte(wc * 32 + fr, fq * 8);
#define PG8_SA(b, h) (((b) * 2 + (h)) * HTB)
#define PG8_SB(b, h) ((4 + (b) * 2 + (h)) * HTB)
#define PG8_STAGE(bufoff, gbase, voff) do { _Pragma("unroll") for (int _i = 0; _i < 2; ++_i) \
        __builtin_amdgcn_global_load_lds((const unsigned*)((const char*)(gbase) + (voff)[_i]), (PG8_LAS unsigned*)(lds + (bufoff) + ldsw + _i * 8192), 16, 0, 0); } while (0)
#define PG8_LDA(dst, b, h) do { _Pragma("unroll") for (int m = 0; m < 4; ++m) _Pragma("unroll") for (int k = 0; k < 2; ++k) dst[m][k] = *(const PG8_LAS bf16x8*)(lds + PG8_SA(b, h) + aoff + m * 2048 + k * 1024); } while (0)
#define PG8_LDB(dst, b, h) do { _Pragma("unroll") for (int n = 0; n < 2; ++n) _Pragma("unroll") for (int k = 0; k < 2; ++k) dst[n][k] = *(const PG8_LAS bf16x8*)(lds + PG8_SB(b, h) + boff + n * 2048 + k * 1024); } while (0)
#define PG8_MMA(ai, bj, At, Bt) do { __builtin_amdgcn_s_setprio(1); _Pragma("unroll") for (int m = 0; m < 4; ++m) _Pragma("unroll") for (int n = 0; n < 2; ++n) _Pragma("unroll") for (int k = 0; k < 2; ++k) \
        acc[ai][bj][m][n] = __builtin_amdgcn_mfma_f32_16x16x32_bf16(Bt[n][k], At[m][k], acc[ai][bj][m][n], 0, 0, 0); __builtin_amdgcn_s_setprio(0); } while (0)
#define PG8_WAIT_V(n) asm volatile("s_waitcnt vmcnt(" #n ")" ::: "memory")
#define PG8_WAIT_L(n) asm volatile("s_waitcnt lgkmcnt(" #n ")" ::: "memory")
#define PG8_BAR __builtin_amdgcn_s_barrier()
#define PG8_SCHED __builtin_amdgcn_sched_barrier(0)
    Unit cur, nxt; int ui = 0;
    if (!S.next(0, cur)) return;
    f32x4 acc[2][2][4][2];
#pragma unroll
    for (int a = 0; a < 2; ++a)
#pragma unroll
        for (int b = 0; b < 2; ++b)
#pragma unroll
            for (int m = 0; m < 4; ++m)
#pragma unroll
                for (int n = 0; n < 2; ++n) acc[a][b][m][n] = (f32x4){0.f, 0.f, 0.f, 0.f};
    bf16x8 At[4][2], B0[2][2], B1[2][2];
    const char* cA = (const char*)g.A + (size_t)cur.pm * tstepA; const char* cB = (const char*)g.Bt + (size_t)cur.pn * tstep;
    S.a_ready(cur);
    if constexpr (SP2) {
        PG8_STAGE(PG8_SB(0, 0), cB, voffB); PG8_STAGE(PG8_SB(0, 1), cB + hstep, voffB); PG8_STAGE(PG8_SA(0, 0), cA, voffA); PG8_STAGE(PG8_SA(0, 1), cA + hstepA, voffA);
        if (wr == 1) PG8_BAR;
        PG8_WAIT_V(2); PG8_BAR;
        PG8_STAGE(PG8_SB(1, 0), cB + kstep, voffB); PG8_STAGE(PG8_SA(1, 0), cA + kstep, voffA); PG8_STAGE(PG8_SB(1, 1), cB + hstep + kstep, voffB);
        PG8_WAIT_V(6); PG8_BAR;
    } else {
        PG8_STAGE(PG8_SB(0, 0), cB, voffB); PG8_STAGE(PG8_SA(0, 0), cA, voffA); PG8_STAGE(PG8_SB(0, 1), cB + hstep, voffB); PG8_STAGE(PG8_SA(0, 1), cA + hstepA, voffA);
        if (wr == 1) PG8_BAR;
        PG8_WAIT_V(4); PG8_BAR;
        PG8_STAGE(PG8_SB(1, 0), cB + kstep, voffB); PG8_STAGE(PG8_SA(1, 0), cA + kstep, voffA); PG8_STAGE(PG8_SB(1, 1), cB + hstep + kstep, voffB);
        PG8_WAIT_V(6); PG8_BAR;
    }
    for (;;) {
        const bool has_next = S.next(ui + 1, nxt);
        const char* nA = has_next ? (const char*)g.A + (size_t)nxt.pm * tstepA : cA; const char* nB = has_next ? (const char*)g.Bt + (size_t)nxt.pn * tstep : cB;
        for (int t = 0; t < nt; t += 2) {
            const bool last = (t == nt - 2);
            const char* a1 = cA + (size_t)(t + 1) * kstep;
            const char* a2 = last ? nA : cA + (size_t)(t + 2) * kstep; const char* b2 = last ? nB : cB + (size_t)(t + 2) * kstep;
            const char* a3 = a2 + kstep; const char* b3 = b2 + kstep;
            if (last && has_next) S.a_ready(nxt);
            if constexpr (SP2) {
            PG8_LDB(B0, 0, 0); PG8_LDB(B1, 0, 1); PG8_SCHED; PG8_LDA(At, 0, 0); PG8_STAGE(PG8_SA(1, 1), a1 + hstepA, voffA);
            PG8_WAIT_V(8); PG8_WAIT_L(0); PG8_BAR; PG8_MMA(0, 0, At, B0); PG8_MMA(0, 1, At, B1); PG8_BAR; PG8_SCHED;
            PG8_LDA(At, 0, 1); PG8_STAGE(PG8_SB(0, 0), b2, voffB); PG8_STAGE(PG8_SB(0, 1), b2 + hstep, voffB); PG8_STAGE(PG8_SA(0, 0), a2, voffA);
            PG8_WAIT_V(8); PG8_WAIT_L(0); PG8_BAR; PG8_MMA(1, 0, At, B0); PG8_MMA(1, 1, At, B1); PG8_BAR; PG8_SCHED;
            PG8_LDB(B0, 1, 0); PG8_LDB(B1, 1, 1); PG8_SCHED; PG8_LDA(At, 1, 0); PG8_STAGE(PG8_SA(0, 1), a2 + hstepA, voffA);
            PG8_WAIT_V(8); PG8_WAIT_L(0); PG8_BAR; PG8_MMA(0, 0, At, B0); PG8_MMA(0, 1, At, B1); PG8_BAR; PG8_SCHED;
            PG8_LDA(At, 1, 1); PG8_STAGE(PG8_SB(1, 0), b3, voffB); PG8_STAGE(PG8_SB(1, 1), b3 + hstep, voffB); PG8_STAGE(PG8_SA(1, 0), a3, voffA);
            PG8_WAIT_V(8); PG8_WAIT_L(0); PG8_BAR; PG8_MMA(1, 0, At, B0); PG8_MMA(1, 1, At, B1); PG8_BAR; PG8_SCHED;
            } else {
            PG8_LDB(B0, 0, 0); PG8_SCHED; PG8_LDA(At, 0, 0); PG8_STAGE(PG8_SA(1, 1), a1 + hstepA, voffA);
            PG8_WAIT_L(8); PG8_BAR; PG8_WAIT_L(0); PG8_MMA(0, 0, At, B0); PG8_BAR; PG8_SCHED;
            PG8_LDB(B1, 0, 1); PG8_STAGE(PG8_SB(0, 0), b2, voffB);
            PG8_BAR; PG8_WAIT_L(0); PG8_MMA(0, 1, At, B1); PG8_BAR;
            PG8_LDA(At, 0, 1); PG8_STAGE(PG8_SA(0, 0), a2, voffA);
            PG8_BAR; PG8_WAIT_L(0); PG8_MMA(1, 0, At, B0); PG8_BAR; PG8_SCHED;
            PG8_STAGE(PG8_SB(0, 1), b2 + hstep, voffB);
            PG8_WAIT_V(6); PG8_BAR; PG8_MMA(1, 1, At, B1); PG8_BAR;
            PG8_LDB(B0, 1, 0); PG8_SCHED; PG8_LDA(At, 1, 0); PG8_STAGE(PG8_SA(0, 1), a2 + hstepA, voffA);
            PG8_WAIT_L(8); PG8_BAR; PG8_WAIT_L(0); PG8_MMA(0, 0, At, B0); PG8_BAR; PG8_SCHED;
            PG8_LDB(B1, 1, 1); PG8_STAGE(PG8_SB(1, 0), b3, voffB);
            PG8_BAR; PG8_WAIT_L(0); PG8_MMA(0, 1, At, B1); PG8_BAR;
            PG8_LDA(At, 1, 1); PG8_STAGE(PG8_SA(1, 0), a3, voffA);
            PG8_BAR; PG8_WAIT_L(0); PG8_MMA(1, 0, At, B0); PG8_BAR; PG8_SCHED;
            PG8_STAGE(PG8_SB(1, 1), b3 + hstep, voffB);
            PG8_WAIT_V(6); PG8_BAR; PG8_MMA(1, 1, At, B1); PG8_BAR;
            }
        }
        if constexpr (ALIGN_EPI) { if (wr == 0) PG8_BAR; }
        if constexpr (!Epi::AFTER_DRAIN) { E(acc, cur, wr, wc, fr, fq); S.done(cur); }
        if (!has_next) break;
#pragma unroll
        for (int a = 0; a < 2; ++a)
#pragma unroll
            for (int b = 0; b < 2; ++b)
#pragma unroll
                for (int m = 0; m < 4; ++m)
#pragma unroll
                    for (int n = 0; n < 2; ++n) acc[a][b][m][n] = (f32x4){0.f, 0.f, 0.f, 0.f};
        cur = nxt; cA = nA; cB = nB; ++ui;
        if constexpr (ALIGN_EPI) { if (wr == 1) PG8_BAR; }
    }
    PG8_WAIT_V(0);
    if constexpr (!ALIGN_EPI) { if (wr == 0) PG8_BAR; }
    PG8_BAR;
    if constexpr (Epi::AFTER_DRAIN) { E.fused(acc, cur, wr, wc, fr, fq, lds, wid, lane); S.done(cur); }
#undef PG8_SA
#undef PG8_SB
#undef PG8_STAGE
#undef PG8_LDA
#undef PG8_LDB
#undef PG8_MMA
#undef PG8_WAIT_V
#undef PG8_WAIT_L
#undef PG8_BAR
#undef PG8_SCHED
}
}
namespace attn_body {
using bf16=__hip_bfloat16;
using bf16x8=__attribute__((ext_vector_type(8)))short;
using s16x4=__attribute__((ext_vector_type(4)))short;
using f32x16=__attribute__((ext_vector_type(16)))float;
using u32x4=__attribute__((ext_vector_type(4)))unsigned;
constexpr int BATCH=4,NHEAD=8,SEQ=8192,D=64,DM=2560;
constexpr int NW=8,QBLK=32,QB=QBLK*NW,KVBLK=64,NQB=SEQ/QB;
constexpr int ATTN_PITCH=DM, ATTN_UNIT_ROWS=QB;
__device__ __forceinline__ int crow(int r,int hi){return (r&3)+8*(r>>2)+4*hi;}
#define SBAR() __builtin_amdgcn_sched_barrier(0)
__device__ __forceinline__ void cmask(f32x16&p0,f32x16&p1,int jb,int qrel,int hi){
  const float NEG=-INFINITY; int kb=64*jb+4*hi;
  #pragma unroll
  for(int r=0;r<16;++r){int kv=kb+(r&3)+8*(r>>2); if(kv>qrel)p0[r]=NEG; if(kv+32>qrel)p1[r]=NEG;}
}

constexpr int NSLOT=3, SLOTB=8192;
constexpr int LDS_K=0, LDS_V=NSLOT*SLOTB, LDS_WS=2*NSLOT*SLOTB, LDS_OST=LDS_WS+NW*128*4, LDS_BYTES=LDS_OST+NW*4096;
constexpr float C2=0.125f*1.4426950408889634f;
__device__ __forceinline__ void glds16(const void*gsrc,unsigned lds_dst){unsigned keep;
  asm volatile("s_mov_b32 %0, m0\n\ts_mov_b32 m0, %2\n\ts_nop 0\n\tglobal_load_lds_dwordx4 %1, off\n\ts_mov_b32 m0, %0":"=&s"(keep):"v"(gsrc),"s"(lds_dst):"memory");}
__device__ __forceinline__ float max3f(float a,float b,float c){float r;asm("v_max3_f32 %0, %1, %2, %3":"=v"(r):"v"(a),"v"(b),"v"(c));return r;}
__device__ __forceinline__ float max2f(float a,float b){float r;asm("v_max_f32_e32 %0, %1, %2":"=v"(r):"v"(a),"v"(b));return r;}
__device__ __forceinline__ float fadd_s(float a,float b){float r;asm("v_add_f32_e32 %0, %1, %2":"=v"(r):"v"(a),"v"(b));return r;}
__device__ __forceinline__ float fsub_s(float a,float b){float r;asm("v_sub_f32_e32 %0, %1, %2":"=v"(r):"v"(a),"v"(b));return r;}
typedef float f32x2_t __attribute__((ext_vector_type(2))); typedef __bf16 bf16x2_t __attribute__((ext_vector_type(2)));
__device__ __forceinline__ unsigned cvtpk_s(float lo,float hi){f32x2_t v={lo,hi};bf16x2_t b=__builtin_convertvector(v,bf16x2_t);return __builtin_bit_cast(unsigned,b);}
#define WAIT_BAR(N) asm volatile("s_waitcnt vmcnt(" #N ") lgkmcnt(0)\n\ts_barrier":::"memory")

__device__ __forceinline__ void qkt(f32x16&p0,f32x16&p1,const char*Kslot,const bf16x8*qr,const f32x16&negm,int r32,int hi){
  const char*kb=Kslot+hi*1024+r32*16;
  #pragma unroll
  for(int d0=0;d0<4;++d0){
    const bf16x8 b0=*reinterpret_cast<const bf16x8*>(kb+d0*2048);
    const bf16x8 b1=*reinterpret_cast<const bf16x8*>(kb+d0*2048+512);
    if(d0==0){p0=__builtin_amdgcn_mfma_f32_32x32x16_bf16(b0,qr[0],negm,0,0,0);p1=__builtin_amdgcn_mfma_f32_32x32x16_bf16(b1,qr[0],negm,0,0,0);}
    else{p0=__builtin_amdgcn_mfma_f32_32x32x16_bf16(b0,qr[d0],p0,0,0,0);p1=__builtin_amdgcn_mfma_f32_32x32x16_bf16(b1,qr[d0],p1,0,0,0);}}
}
typedef __attribute__((address_space(3))) const char* lds_cptr;
typedef short v4i16_t __attribute__((ext_vector_type(4)));
__device__ __forceinline__ void kload8(bf16x8*kf,lds_cptr kp){
  kf[0]=*(const __attribute__((address_space(3))) bf16x8*)(kp);      kf[1]=*(const __attribute__((address_space(3))) bf16x8*)(kp+512);
  kf[2]=*(const __attribute__((address_space(3))) bf16x8*)(kp+2048); kf[3]=*(const __attribute__((address_space(3))) bf16x8*)(kp+2560);
  kf[4]=*(const __attribute__((address_space(3))) bf16x8*)(kp+4096); kf[5]=*(const __attribute__((address_space(3))) bf16x8*)(kp+4608);
  kf[6]=*(const __attribute__((address_space(3))) bf16x8*)(kp+6144); kf[7]=*(const __attribute__((address_space(3))) bf16x8*)(kp+6656);
}
__device__ __forceinline__ void kload2(bf16x8*kf,lds_cptr kp,int j){ kf[2*j]=*(const __attribute__((address_space(3))) bf16x8*)(kp+j*2048); kf[2*j+1]=*(const __attribute__((address_space(3))) bf16x8*)(kp+j*2048+512); }
__device__ __forceinline__ s16x4 vtr(lds_cptr p){ return __builtin_bit_cast(s16x4,__builtin_amdgcn_ds_read_tr16_b64_v4i16((__attribute__((address_space(3))) v4i16_t*)p)); }
__device__ __forceinline__ float rowmax(const f32x16&p0,const f32x16&p1){
  float a=max3f(p0[0],p0[1],p1[0]),b=max3f(p0[2],p0[3],p1[1]);a=max3f(a,p1[2],p1[3]);
  #pragma unroll
  for(int r=4;r<16;r+=4){a=max3f(a,p0[r],p0[r+1]);b=max3f(b,p0[r+2],p0[r+3]);a=max3f(a,p1[r],p1[r+1]);b=max3f(b,p1[r+2],p1[r+3]);}
  const float m=max2f(a,b);
  auto rr=__builtin_amdgcn_permlane32_swap(__float_as_uint(m),__float_as_uint(m),false,false);
  return max2f(__uint_as_float(rr[0]),__uint_as_float(rr[1]));
}
__device__ __forceinline__ void pv(f32x16*o,int vb,bf16x8 pa0,bf16x8 pa1,bf16x8 pa2,bf16x8 pa3){
  #pragma unroll
  for(int d0=0;d0<2;++d0){s16x4 lo[4],hi[4];
    #pragma unroll
    for(int ks=0;ks<4;++ks){
      asm volatile("ds_read_b64_tr_b16 %0,%1 offset:%c2":"=&v"(lo[ks]):"v"(vb),"i"(d0*4096+ks*1024):"memory");
      asm volatile("ds_read_b64_tr_b16 %0,%1 offset:%c2":"=&v"(hi[ks]):"v"(vb),"i"(d0*4096+ks*1024+512):"memory");}
    asm volatile("s_waitcnt lgkmcnt(0)":::"memory");SBAR();
    #define PK(k) (bf16x8){lo[k][0],lo[k][1],lo[k][2],lo[k][3],hi[k][0],hi[k][1],hi[k][2],hi[k][3]}
    o[d0]=__builtin_amdgcn_mfma_f32_32x32x16_bf16(pa0,PK(0),o[d0],0,0,0);
    o[d0]=__builtin_amdgcn_mfma_f32_32x32x16_bf16(pa1,PK(1),o[d0],0,0,0);
    o[d0]=__builtin_amdgcn_mfma_f32_32x32x16_bf16(pa2,PK(2),o[d0],0,0,0);
    o[d0]=__builtin_amdgcn_mfma_f32_32x32x16_bf16(pa3,PK(3),o[d0],0,0,0);
    #undef PK
  }
}

#ifndef ATTN_STORE16
#define ATTN_STORE16(p,v) (*(u32x4*)(p)=(v))
#endif
template<int THRL> __device__ __forceinline__ void attn_unit(int b,int h,int qb,const bf16*Q,const bf16*__restrict__ K,const bf16*__restrict__ V,bf16*O,const unsigned*__restrict__ SEL,char*shm){
  int tid_=threadIdx.x; asm volatile("":"+v"(tid_)); const int tid=tid_,lane=tid&63,r32=lane&31,hi=lane>>5; const int wid=__builtin_amdgcn_readfirstlane(tid>>6);
  const long rowbase=(long)b*SEQ; const int q0=qb*QB;
  const bf16*Qw=Q+(rowbase+q0+wid*QBLK)*DM+h*D;
  const bf16*Kh=K+rowbase*DM+h*D,*Vh=V+rowbase*DM+h*D;
  const unsigned lds0=(unsigned)(uintptr_t)shm;
  float*wsf=(float*)(shm+LDS_WS)+wid*128;
  const bf16*ksrc=Kh+(long)lane*DM+wid*8;
  const bf16*vsrc=Vh+(long)(16*(wid&3)+(lane>>2))*DM+(wid>>2)*32+(lane&3)*8;
  const unsigned kdst=lds0+LDS_K+wid*1024, vdst=lds0+LDS_V+wid*1024;
  #define DMA_K(t,slot) glds16(ksrc+(long)(t)*KVBLK*DM,(unsigned)__builtin_amdgcn_readfirstlane(kdst+(slot)))
  #define DMA_V(t,slot) glds16(vsrc+(long)(t)*KVBLK*DM,(unsigned)__builtin_amdgcn_readfirstlane(vdst+(slot)))
  const int vb0=(int)(lds0+LDS_V)+((lane>>4)&1)*32+(lane&3)*8+(4*hi+((lane&15)>>2))*64;
  const char*Kbase=shm+LDS_K; bf16x8 kf[8];
  const lds_cptr shm3=(lds_cptr)shm; const lds_cptr kp0=shm3+LDS_K+hi*1024+r32*16; const lds_cptr vp0=shm3+LDS_V+((lane>>4)&1)*32+(lane&3)*8+(4*hi+((lane&15)>>2))*64;
  const int NT=(q0+QB)/KVBLK;
  DMA_K(0,0);DMA_V(0,0);DMA_K(1,SLOTB);
  bf16x8 qr[4];
  #pragma unroll
  for(int d0=0;d0<4;++d0)qr[d0]=*reinterpret_cast<const bf16x8*>(&Qw[(long)r32*DM+d0*16+hi*8]);
  float mhat=0.f,l_reg=0.f;f32x16 o[2];o[0]=f32x16{};o[1]=f32x16{};const f32x16 negm=f32x16{};
  const int qrel=wid*QBLK+r32;
  unsigned*selp=(unsigned*)(wsf+64);
  if(hi==0)selp[r32]=SEL[(size_t)(rowbase+q0+qrel)*NHEAD+h];
  #define MOBA(P0,P1,t) do{ const unsigned sel_=selp[r32]; if(!((sel_>>((t)>>2))&1u)){ _Pragma("unroll") for(int r_=0;r_<16;++r_){P0[r_]=-INFINITY;P1[r_]=-INFINITY;} } }while(0)
  #define CMASK(P0,P1,t) do{int jb_=(t)-(NT-4); if(jb_>=0)cmask(P0,P1,jb_,qrel,hi); else MOBA(P0,P1,t);}while(0)
  bool resc=false;
  #define START(P0,P1) do{ const float rm=rowmax(P0,P1); resc=false; \
    { const float dl=(rm==-INFINITY)?0.f:rm; mhat=fadd_s(mhat,dl); \
      _Pragma("unroll") for(int r=0;r<16;++r){P0[r]=fsub_s(P0[r],dl);P1[r]=fsub_s(P1[r],dl);} \
      } \
    _Pragma("unroll") for(int r=0;r<16;++r)P0[r]=__builtin_amdgcn_exp2f(P0[r]); }while(0)
  #define RESC() do{ if(resc){ asm volatile("s_waitcnt lgkmcnt(0)":::"memory"); \
      _Pragma("unroll") for(int d_=0;d_<2;++d_) _Pragma("unroll") for(int r=0;r<16;++r)o[d_][r]*=wsf[crow(r,hi)]; } }while(0)
  f32x16 pA0,pA1,pB0,pB1;
  int sl_prev=0,sl_cur=0,sl_next=SLOTB;
  #define ROT() do{sl_prev=sl_cur;sl_cur=sl_next;sl_next=(sl_next==(NSLOT-1)*SLOTB)?0:sl_next+SLOTB;}while(0)
  DMA_K(2,2*SLOTB);
  WAIT_BAR(3);
  qkt(pA0,pA1,Kbase,qr,negm,r32,hi);asm volatile("s_nop 15\n\ts_nop 7":"+v"(pA0),"+v"(pA1));CMASK(pA0,pA1,0);
  START(pA0,pA1);
  _Pragma("unroll") for(int r=0;r<16;++r)pA1[r]=__builtin_amdgcn_exp2f(pA1[r]);
  WAIT_BAR(0);
  DMA_K(3,0);DMA_V(1,SLOTB);
  ROT();
  kload8(kf,kp0+sl_cur);
  WAIT_BAR(2);
  s16x4 vlo[8],vhi[8]; u32x4 pw0,pw1,pw2,pw3;
  #define PKW(P,B) cvtpk_s(P[B],P[B+1])
  #define PAF(k) __builtin_bit_cast(bf16x8,pw##k)
  #define VFR(i) (bf16x8){vlo[i][0],vlo[i][1],vlo[i][2],vlo[i][3],vhi[i][0],vhi[i][1],vhi[i][2],vhi[i][3]}
  #define PIN(x) asm volatile("":"+v"(x))
  #define MX3(a,b,c) __builtin_fmaxf(__builtin_fmaxf((a),(b)),(c))
  #define GAPA(MF,A0,A1,A2,A3,W0,W1,PW) do{ MF; sacc+=A0; sacc+=A1; sacc+=A2; sacc+=A3; PIN(sacc); W0; W1; PIN(PW); SBAR(); }while(0)
  #define EX(v) __builtin_amdgcn_exp2f(v)
  #define GAPB(MF,X,B) do{ MF; X[B]=EX(X[B]); X[B+1]=EX(X[B+1]); X[B+2]=EX(X[B+2]); X[B+3]=EX(X[B+3]); PIN(X); SBAR(); }while(0)
  #define VRD(i) do{ vlo[i]=vtr(vp_+(((i)>>2)*4096+((i)&3)*1024)); vhi[i]=vtr(vp_+(((i)>>2)*4096+((i)&3)*1024+512)); }while(0)
  #define KRD(G,j) do{ if(G){ kload2(kf,kp0+sl_next,j); SBAR(); } }while(0)
  #define STEP(C0,C1,P0,P1,t,GK,GV,GL) do{ SBAR(); \
    const lds_cptr vp_=vp0+sl_prev; \
    VRD(0); SBAR(); float sacc=(P0[0]+P0[1]); \
    GAPA(C0=__builtin_amdgcn_mfma_f32_32x32x16_bf16(kf[0],qr[0],negm,0,0,0), P0[2],P0[3],P0[4],P0[5],     pw0[0]=PKW(P0,0), pw0[1]=PKW(P0,2), pw0); \
    VRD(4); SBAR(); GAPA(C1=__builtin_amdgcn_mfma_f32_32x32x16_bf16(kf[1],qr[0],negm,0,0,0), P0[6],P0[7],P0[8],P0[9],     pw0[2]=PKW(P0,4), pw0[3]=PKW(P0,6), pw0); \
    VRD(1); SBAR(); GAPA(C0=__builtin_amdgcn_mfma_f32_32x32x16_bf16(kf[2],qr[1],C0,0,0,0),   P0[10],P0[11],P0[12],P0[13], pw1[0]=PKW(P0,8), pw1[1]=PKW(P0,10), pw1); \
    VRD(5); SBAR(); GAPA(C1=__builtin_amdgcn_mfma_f32_32x32x16_bf16(kf[3],qr[1],C1,0,0,0),   P0[14],P0[15],P1[0],P1[1],   pw1[2]=PKW(P0,12),pw1[3]=PKW(P0,14), pw1); \
    VRD(2); SBAR(); GAPA(C0=__builtin_amdgcn_mfma_f32_32x32x16_bf16(kf[4],qr[2],C0,0,0,0),   P1[2],P1[3],P1[4],P1[5],     pw2[0]=PKW(P1,0), pw2[1]=PKW(P1,2), pw2); \
    VRD(6); SBAR(); GAPA(C1=__builtin_amdgcn_mfma_f32_32x32x16_bf16(kf[5],qr[2],C1,0,0,0),   P1[6],P1[7],P1[8],P1[9],     pw2[2]=PKW(P1,4), pw2[3]=PKW(P1,6), pw2); \
    VRD(3); SBAR(); GAPA(C0=__builtin_amdgcn_mfma_f32_32x32x16_bf16(kf[6],qr[3],C0,0,0,0),   P1[10],P1[11],P1[12],P1[13], pw3[0]=PKW(P1,8), pw3[1]=PKW(P1,10), pw3); \
    VRD(7); SBAR(); GAPA(C1=__builtin_amdgcn_mfma_f32_32x32x16_bf16(kf[7],qr[3],C1,0,0,0),   P1[14],P1[15],0.f,0.f,       pw3[2]=PKW(P1,12),pw3[3]=PKW(P1,14), pw3); \
    l_reg+=sacc; \
    if(GK){DMA_K((t)+3,sl_cur);} if(GV){DMA_V((t)+1,sl_next);} \
    _Pragma("unroll") for(int r=0;r<16;++r){C0[r]-=mhat;C1[r]-=mhat;} \
    CMASK(C0,C1,t); \
    { float a=MX3(C0[0],C0[1],C1[0]),b=MX3(C0[2],C0[3],C1[1]); a=MX3(a,C1[2],C1[3]); \
      _Pragma("unroll") for(int r=4;r<16;r+=4){a=MX3(a,C0[r],C0[r+1]);b=MX3(b,C0[r+2],C0[r+3]);a=MX3(a,C1[r],C1[r+1]);b=MX3(b,C1[r+2],C1[r+3]);} \
      float rm=__builtin_fmaxf(a,b); { auto rr=__builtin_amdgcn_permlane32_swap(__float_as_uint(rm),__float_as_uint(rm),false,false); rm=__builtin_fmaxf(__uint_as_float(rr[0]),__uint_as_float(rr[1])); } \
      resc=false; \
      if(__builtin_expect(__any(rm>(float)THRL),0)){ const float dl=__builtin_fmaxf(rm,0.f); mhat+=dl; \
        _Pragma("unroll") for(int r=0;r<16;++r){C0[r]-=dl;C1[r]-=dl;} \
        const float f=__builtin_amdgcn_exp2f(-dl); l_reg*=f; if(hi==0)wsf[r32]=f; resc=true; } } \
    SBAR(); \
    GAPB(o[0]=__builtin_amdgcn_mfma_f32_32x32x16_bf16(PAF(0),VFR(0),o[0],0,0,0), C0,0); \
    GAPB(o[1]=__builtin_amdgcn_mfma_f32_32x32x16_bf16(PAF(0),VFR(4),o[1],0,0,0), C0,4); \
    KRD(GL,0); GAPB(o[0]=__builtin_amdgcn_mfma_f32_32x32x16_bf16(PAF(1),VFR(1),o[0],0,0,0), C0,8); \
    KRD(GL,1); GAPB(o[1]=__builtin_amdgcn_mfma_f32_32x32x16_bf16(PAF(1),VFR(5),o[1],0,0,0), C0,12); \
    KRD(GL,2); GAPB(o[0]=__builtin_amdgcn_mfma_f32_32x32x16_bf16(PAF(2),VFR(2),o[0],0,0,0), C1,0); \
    KRD(GL,3); GAPB(o[1]=__builtin_amdgcn_mfma_f32_32x32x16_bf16(PAF(2),VFR(6),o[1],0,0,0), C1,4); \
    GAPB(o[0]=__builtin_amdgcn_mfma_f32_32x32x16_bf16(PAF(3),VFR(3),o[0],0,0,0), C1,8); \
    GAPB(o[1]=__builtin_amdgcn_mfma_f32_32x32x16_bf16(PAF(3),VFR(7),o[1],0,0,0), C1,12); \
    }while(0)
  int t=1;
  #undef CMASK
  #define CMASK(P0,P1,t) MOBA(P0,P1,t)
  for(;t+5<NT;t+=2){
    STEP(pB0,pB1,pA0,pA1,t,true,true,true);     WAIT_BAR(2); RESC(); ROT();
    STEP(pA0,pA1,pB0,pB1,t+1,true,true,true);   WAIT_BAR(2); RESC(); ROT();
  }
  #undef CMASK
  #define CMASK(P0,P1,t) do{int jb_=(t)-(NT-4); if(jb_>=0)cmask(P0,P1,jb_,qrel,hi); else MOBA(P0,P1,t);}while(0)
  #define ENDW(tt) do{ if((tt)+3<NT){WAIT_BAR(2);} else if((tt)+2<NT){WAIT_BAR(1);} else {WAIT_BAR(0);} }while(0)
  for(;t+1<NT;t+=2){
    STEP(pB0,pB1,pA0,pA1,t,(t+3<NT),(t+1<NT),(t+1<NT));       ENDW(t);   RESC(); ROT();
    STEP(pA0,pA1,pB0,pB1,t+1,(t+4<NT),(t+2<NT),(t+2<NT));     ENDW(t+1); RESC(); ROT();
  }
  STEP(pB0,pB1,pA0,pA1,NT-1,false,false,false); RESC();
  { float sacc=pB0[0]+pB0[1]; _Pragma("unroll") for(int r=2;r<16;++r)sacc+=pB0[r]; _Pragma("unroll") for(int r=0;r<16;++r)sacc+=pB1[r]; l_reg+=sacc;
    pw0=(u32x4){PKW(pB0,0),PKW(pB0,2),PKW(pB0,4),PKW(pB0,6)};pw1=(u32x4){PKW(pB0,8),PKW(pB0,10),PKW(pB0,12),PKW(pB0,14)};pw2=(u32x4){PKW(pB1,0),PKW(pB1,2),PKW(pB1,4),PKW(pB1,6)};pw3=(u32x4){PKW(pB1,8),PKW(pB1,10),PKW(pB1,12),PKW(pB1,14)};
    SBAR(); pv(o,vb0+sl_cur,PAF(0),PAF(1),PAF(2),PAF(3)); }
  #undef PKW
  #undef PAF
  #undef VFR
  #undef PIN
  #undef MX3
  #undef GAPA
  #undef GAPB
  #undef EX
  #undef VRD
  #undef KRD
  #undef STEP
  #undef ENDW
  {auto rr=__builtin_amdgcn_permlane32_swap(__float_as_uint(l_reg),__float_as_uint(l_reg),false,false);l_reg=__uint_as_float(rr[0])+__uint_as_float(rr[1]);}
  if(hi==0)wsf[32+r32]=l_reg;asm volatile("s_waitcnt lgkmcnt(0)":::"memory");
  float rli[16];
  #pragma unroll
  for(int r=0;r<16;++r)rli[r]=__builtin_amdgcn_rcpf(wsf[32+crow(r,hi)]);
  bf16*Ow=O+(rowbase+q0+wid*QBLK)*DM+h*D;
  { bf16*stg=(bf16*)(shm+LDS_OST)+wid*2048;
    #pragma unroll
    for(int r=0;r<16;++r){const int orow=crow(r,hi);
      #pragma unroll
      for(int d0=0;d0<2;++d0)stg[orow*64+d0*32+r32]=__float2bfloat16(o[d0][r]*rli[r]);}
    asm volatile("s_waitcnt lgkmcnt(0)":::"memory");
    #pragma unroll
    for(int i=0;i<4;++i){const int row=i*8+(lane>>3),ch=lane&7; const u32x4 v=*(const u32x4*)(stg+row*64+ch*8); ATTN_STORE16(Ow+(long)row*DM+ch*8,v);} }
  asm volatile("s_waitcnt lgkmcnt(0)\n\ts_barrier":::"memory");
  #undef DMA_K
  #undef DMA_V
  #undef CMASK
  #undef MOBA
  #undef START
  #undef RESC
  #undef ROT
}
constexpr int ATTN_LDS_BYTES=LDS_BYTES;
struct AttnTensors { const bf16* Q; const bf16* K; const bf16* V; bf16* O; const unsigned* SEL; };
struct AttnUnit { int bh; int qb; };
struct StaticOrder {
  int vcu;
  __device__ __forceinline__ explicit StaticOrder(int grid,int block):vcu((block%8)*(grid/8)+block/8){}
  __device__ __forceinline__ bool next(int i,AttnUnit&u)const{ if(i>=4)return false; const int s=vcu&7; u.bh=vcu>>3; u.qb=(i==0)?s:(i==1)?15-s:(i==2)?16+s:31-s; return true; }
  __device__ __forceinline__ void a_ready(const AttnUnit&)const{}
  __device__ __forceinline__ void done(const AttnUnit&)const{}
};
template<class Sched,int THRL=8> __device__ __forceinline__ void attn_phase(char*lds,const AttnTensors&T,const Sched&S){
  AttnUnit u;
  for(int i=0;S.next(i,u);++i){ S.a_ready(u); attn_unit<THRL>(u.bh/NHEAD,u.bh%NHEAD,u.qb,T.Q,T.K,T.V,T.O,T.SEL,lds); S.done(u); }
}
#undef SBAR
#undef WAIT_BAR
}
#define LAS __attribute__((address_space(3)))
#define GASP __attribute__((address_space(1)))
typedef unsigned short bf16_t;
typedef unsigned v4u __attribute__((ext_vector_type(4)));
typedef unsigned v2u __attribute__((ext_vector_type(2)));
typedef float f32x4 __attribute__((ext_vector_type(4)));
typedef short bf16x8 __attribute__((ext_vector_type(8)));

constexpr int NB = 4, SEQ = 8192, T = NB * SEQ, D = 1024, FF = 2816;
constexpr int AB_IN = 2560, C_INW = 3080, C_PROJ = 3072;
constexpr float ALPHA = 1.4142135623730951f;
constexpr float LN_EPS = 1e-5f;
constexpr int NWAVES = 8;
constexpr size_t MiB = 1u << 20;
constexpr size_t WS_ROPE = 1 * MiB;
constexpr size_t WS_WGU = 3 * MiB;
constexpr size_t WS_WD = WS_WGU + 44 * MiB;
constexpr size_t WS_WABI = WS_WD + 22 * MiB;
constexpr size_t WS_WABO = WS_WABI + 5 * MiB;
constexpr size_t WS_WCI = WS_WABO + 2 * MiB;
constexpr size_t WS_WCO = WS_WCI + 6 * MiB;
constexpr size_t WS_SMALL = WS_WCO + 2 * MiB;
constexpr size_t WS_KMEAN = WS_SMALL;
constexpr size_t WS_STATS = WS_SMALL + 1 * MiB;
constexpr size_t WS_SEL = WS_SMALL + 2 * MiB;
constexpr size_t WS_GATES = WS_SMALL + 3 * MiB;
constexpr size_t WS_WIF = WS_SMALL + 4 * MiB;
constexpr size_t WS_BEND = WS_SMALL + 5 * MiB;
constexpr size_t WS_AMAX = WS_BEND + 8192;
constexpr size_t WS_MIN = WS_AMAX + 8192;
constexpr size_t WS_KS = WS_SMALL + 6 * MiB;
constexpr size_t WS_NIN = WS_SMALL + 7 * MiB;
constexpr size_t WS_XB = 96 * MiB;
constexpr size_t WS_BIG = 160 * MiB;
constexpr size_t WS_Y = 352 * MiB;
constexpr size_t WS_END = 480 * MiB;
static_assert(WS_SMALL + 8 * MiB <= WS_XB, "ws map");
constexpr int LDS_BYTES = 147456, LDS_MISC = 147456 - 256;

__device__ __forceinline__ unsigned f2bf(float f) { unsigned u = __builtin_bit_cast(unsigned, f); return (u + 0x7fffu + ((u >> 16) & 1u)) >> 16; }
__device__ __forceinline__ unsigned pk2(float lo, float hi) { return f2bf(lo) | (f2bf(hi) << 16); }
__device__ __forceinline__ float bf2f(unsigned short b) { return __builtin_bit_cast(float, (unsigned)b << 16); }
__device__ __forceinline__ float bflo(unsigned w) { return __builtin_bit_cast(float, w << 16); }
__device__ __forceinline__ float bfhi(unsigned w) { return __builtin_bit_cast(float, w & 0xffff0000u); }
__device__ __forceinline__ float wave_sum(float v) {
#pragma unroll
    for (int o = 1; o < 64; o <<= 1) v += __shfl_xor(v, o);
    return v;
}
__device__ __forceinline__ float wave_max(float v) {
#pragma unroll
    for (int o = 1; o < 64; o <<= 1) v = fmaxf(v, __shfl_xor(v, o));
    return v;
}

#define XB_TMO      128
#define XB_XCNT(j)  (256  + 64 * (j))
#define XB_XSUB(j)  (1280 + 64 * (j))
#define XB_XGEN(j)  (2304 + 64 * (j))
#define XB_TOP      3328
#define XB_TOPGEN   3392
#define XCD_BAR_WORDS 3456
#define XB_SPIN_CAP (1u << 18)

__device__ __forceinline__ unsigned xb_ld(unsigned* p)              { return __hip_atomic_load(p, __ATOMIC_RELAXED, __HIP_MEMORY_SCOPE_AGENT); }
__device__ __forceinline__ unsigned xb_add(unsigned* p, unsigned v) { return __hip_atomic_fetch_add(p, v, __ATOMIC_RELAXED, __HIP_MEMORY_SCOPE_AGENT); }
__device__ __forceinline__ unsigned xb_xcc_id() { return (unsigned)__builtin_amdgcn_s_getreg((3 << 11) | 20) & 0xFu; }
#define XB_SPIN(cond, bar) do { unsigned _sp = 0; while (cond) { __builtin_amdgcn_s_sleep(1); \
    if ((++_sp & 255u) == 0u) { if (xb_ld(&(bar)[XB_TMO])) break; if (_sp > XB_SPIN_CAP) { atomicAdd(&(bar)[XB_TMO], 1u); break; } } } } while (0)

struct XcdBarrier {
    unsigned* bar; unsigned x;
    volatile LAS unsigned* st;
};

__device__ __forceinline__ XcdBarrier xcd_barrier_post(unsigned* bar, volatile LAS unsigned* st) {
    XcdBarrier b; b.bar = bar; b.x = xb_xcc_id(); b.st = st;
    if (threadIdx.x == 0) (void)xb_add(&bar[XB_XCNT(b.x)], 1u);
    return b;
}
__device__ __forceinline__ void xcd_barrier_complete(unsigned* bar, unsigned x, unsigned& nloc, unsigned& nx) {
    const unsigned G = gridDim.x * gridDim.y * gridDim.z;
    unsigned sum, cnt, mine, sp = 0u;
    for (;;) {
        sum = 0u; cnt = 0u; mine = 0u;
#pragma unroll
        for (unsigned j = 0; j < 16; ++j) { const unsigned c = xb_ld(&bar[XB_XCNT(j)]); sum += c; cnt += (c > 0u) ? 1u : 0u; mine = (j == x) ? c : mine; }
        if (sum == G) break;
        __builtin_amdgcn_s_sleep(1);
        if ((++sp & 255u) == 0u) { if (xb_ld(&bar[XB_TMO])) break; if (sp > XB_SPIN_CAP) { atomicAdd(&bar[XB_TMO], 1u); break; } }
    }
    nloc = mine > 0u ? mine : 1u; nx = cnt > 0u ? cnt : 1u;
}

__device__ __forceinline__ void xcd_barrier(const XcdBarrier& b) {
    asm volatile("s_waitcnt vmcnt(0)" ::: "memory");
    __syncthreads();
    if (threadIdx.x == 0) {
        unsigned* bar = b.bar;
        __builtin_amdgcn_s_waitcnt(0);
        unsigned nloc = b.st[0], nx = b.st[1];
        if (nloc == 0u) { xcd_barrier_complete(bar, b.x, nloc, nx); b.st[0] = nloc; b.st[1] = nx; }
        const unsigned old = xb_add(&bar[XB_XSUB(b.x)], 1u);
        const unsigned gen = old / nloc;
        if (old + 1u == (gen + 1u) * nloc) {
            __builtin_amdgcn_fence(__ATOMIC_RELEASE, "agent");
            asm volatile("s_waitcnt vmcnt(0)" ::: "memory");
            const unsigned og = xb_add(&bar[XB_TOP], 1u);
            const unsigned tg = og / nx;
            if (og + 1u == (tg + 1u) * nx) xb_add(&bar[XB_TOPGEN], 1u);
            else XB_SPIN(xb_ld(&bar[XB_TOPGEN]) == tg, bar);
            __builtin_amdgcn_fence(__ATOMIC_ACQUIRE, "agent");
            xb_add(&bar[XB_XGEN(b.x)], 1u);
            asm volatile("s_waitcnt vmcnt(0)" ::: "memory");
        } else {
            XB_SPIN(xb_ld(&bar[XB_XGEN(b.x)]) == gen, bar);
            __builtin_amdgcn_fence(__ATOMIC_ACQUIRE, "agent");
            asm volatile("s_waitcnt vmcnt(0)" ::: "memory");
        }
    }
    __syncthreads();
}

typedef const __attribute__((address_space(4))) unsigned long long* KP;
struct Args { const float* in[18]; float* out; unsigned char* ws; int ph_lo, ph_hi; };

__device__ __forceinline__ void tr_item(const float* W, int ldw, int K, bf16_t* WT, int drow0, int scol0, int k0, LAS float* scr, int lane) {
#pragma unroll 8
    for (int i = 0; i < 32; ++i) { const int kk = 2 * i + (lane >> 5); scr[kk * 33 + (lane & 31)] = W[(size_t)(k0 + kk) * ldw + scol0 + (lane & 31)]; }
    asm volatile("s_waitcnt lgkmcnt(0)" ::: "memory");
    const int c = lane & 7;
#pragma unroll
    for (int j = 0; j < 4; ++j) { const int n = (lane >> 3) + 8 * j; const LAS float* s = scr + (8 * c) * 33 + n;
        v4u o; o.x = pk2(s[0 * 33], s[1 * 33]); o.y = pk2(s[2 * 33], s[3 * 33]); o.z = pk2(s[4 * 33], s[5 * 33]); o.w = pk2(s[6 * 33], s[7 * 33]);
        *(v4u*)(WT + (size_t)(drow0 + n) * K + k0 + 8 * c) = o; }
    asm volatile("s_waitcnt lgkmcnt(0)" ::: "memory");
}
__device__ __forceinline__ int abin_srccol(int d) {
    const int pn = d >> 8, jj = d & 255;
    if (pn <= 1 || pn == 4 || pn == 5) { const int bj = jj >> 7, r = jj & 127, hl = r >> 5, i = r & 31; const int head = 4 * (pn & 1) + hl; return (pn >= 4 ? 512 : 0) + 64 * head + 32 * bj + i; }
    if (pn == 2 || pn == 3) return 1536 + (d - 512);
    if (pn == 6 || pn == 7) return 1024 + (d - 1536);
    return d;
}
__device__ __forceinline__ void prologue(KP kp, LAS unsigned char* lds, int gw, int ngw, int wave) {
    int lane; { int l_ = threadIdx.x; asm volatile("" : "+v"(l_)); lane = l_ & 63; }
    LAS float* scr = (LAS float*)(lds + wave * 16384);
    unsigned char* ws = (unsigned char*)(GASP unsigned char*)kp[19];
    constexpr int I_GU = 16 * 176, I_D = 44 * 32, I_ABI = 16 * 80, I_SQ = 16 * 32, I_CI = 16 * 96;
    constexpr int NITEMS = 4 * I_GU + 4 * I_D + I_ABI + I_SQ + I_CI + I_SQ;
    for (int it = gw; it < NITEMS; it += ngw) {
        int r = it;
        if (r < 4 * I_GU) { const int mi = r / I_GU, q = r % I_GU, kb = q / 176, nb = q % 176; const int d = nb * 32, pn = d >> 8, jj = d & 255;
            const int sc = (jj < 128) ? (128 * pn + jj) : (FF + 128 * pn + jj - 128);
            tr_item(((const float*)(GASP const float*)kp[3]) + (size_t)mi * D * 2 * FF, 2 * FF, D, (bf16_t*)(ws + WS_WGU) + (size_t)mi * 2 * FF * D, d, sc, kb * 64, scr, lane); continue; }
        r -= 4 * I_GU;
        if (r < 4 * I_D) { const int mi = r / I_D, q = r % I_D, kb = q / 32, nb = q % 32;
            tr_item(((const float*)(GASP const float*)kp[4]) + (size_t)mi * FF * D, D, FF, (bf16_t*)(ws + WS_WD) + (size_t)mi * D * FF, nb * 32, nb * 32, kb * 64, scr, lane); continue; }
        r -= 4 * I_D;
        if (r < I_ABI) { const int kb = r / 80, nb = r % 80; tr_item(((const float*)(GASP const float*)kp[5]), AB_IN, D, (bf16_t*)(ws + WS_WABI), nb * 32, abin_srccol(nb * 32), kb * 64, scr, lane); continue; }
        r -= I_ABI;
        if (r < I_SQ) { const int kb = r / 32, nb = r % 32; tr_item(((const float*)(GASP const float*)kp[10]), D, D, (bf16_t*)(ws + WS_WABO), nb * 32, nb * 32, kb * 64, scr, lane); continue; }
        r -= I_SQ;
        if (r < I_CI) { const int kb = r / 96, nb = r % 96; tr_item(((const float*)(GASP const float*)kp[11]), C_INW, D, (bf16_t*)(ws + WS_WCI), nb * 32, nb * 32, kb * 64, scr, lane); continue; }
        r -= I_CI;
        { const int kb = r / 32, nb = r % 32; tr_item(((const float*)(GASP const float*)kp[17]), D, D, (bf16_t*)(ws + WS_WCO), nb * 32, nb * 32, kb * 64, scr, lane); }
    }
    const int gt = gw * 64 + lane, ngt = ngw * 64;
    { const f32x4* x4 = (const f32x4*)((const float*)(GASP const float*)kp[0]); v4u* xb = (v4u*)(ws + WS_XB);
      for (int i = gt; i < T * D / 8; i += ngt) { const f32x4 p = x4[2 * i], q = x4[2 * i + 1]; v4u o; o.x = pk2(p.x, p.y); o.y = pk2(p.z, p.w); o.z = pk2(q.x, q.y); o.w = pk2(q.z, q.w); xb[i] = o; } }
    { float* wif = (float*)(ws + WS_WIF); for (int i = gt; i < 8 * D; i += ngt) { const int j = i >> 10, k = i & 1023; wif[i] = ((const float*)(GASP const float*)kp[11])[(size_t)k * C_INW + C_PROJ + j]; } }
    { float* rc = (float*)(ws + WS_ROPE); float* rs = rc + SEQ * 32;
      for (int i = gt; i < SEQ * 32; i += ngt) { const int pos = i >> 5, fi = i & 31;
          double inv = 1.0; const double r = 0.7498942093324559; for (int k = 0; k < fi; ++k) inv *= r;
          const float invf = (float)inv; const float angf = (float)pos * invf; const double ang = (double)angf;
          const double qd = rint(ang * 0.6366197723675814); const double s = fma(-qd, 1.5707963267948966, ang) - qd * 6.123233995736766e-17;
          const double s2 = s * s;
          const double sn = s * (1.0 + s2 * (-1.0 / 6 + s2 * (1.0 / 120 + s2 * (-1.0 / 5040 + s2 * (1.0 / 362880 + s2 * (-1.0 / 39916800))))));
          const double cs = 1.0 + s2 * (-0.5 + s2 * (1.0 / 24 + s2 * (-1.0 / 720 + s2 * (1.0 / 40320 + s2 * (-1.0 / 3628800 + s2 * (1.0 / 479001600))))));
          const int qi = ((int)qd) & 3; double c, sv;
          if (qi == 0) { c = cs; sv = sn; } else if (qi == 1) { c = -sn; sv = cs; } else if (qi == 2) { c = -cs; sv = -sn; } else { c = sn; sv = -cs; }
          rc[i] = (float)c; rs[i] = (float)sv; } }
}

__device__ __forceinline__ void ln_phase(const float* xin, const float* y, float ys, const float* g, const float* b, float* xout, bf16_t* xb,
                                         const float* wif, float* gates, const float* b_i, const float* b_f, LAS unsigned char* lds, int gw, int ngw) {
    LAS float* wl = (LAS float*)lds;
    int lane; { int l_ = threadIdx.x; asm volatile("" : "+v"(l_)); lane = l_ & 63; }
    if (wif) { for (int i = threadIdx.x; i < 8 * D / 4; i += NWAVES * 64) ((LAS f32x4*)wl)[i] = ((const f32x4*)wif)[i]; __syncthreads(); }
    f32x4 gv[4], bv[4];
#pragma unroll
    for (int j = 0; j < 4; ++j) { gv[j] = ((const f32x4*)g)[lane + 64 * j]; bv[j] = ((const f32x4*)b)[lane + 64 * j]; }
    for (int row = gw; row < T; row += ngw) {
        const f32x4* xr = (const f32x4*)(xin + (size_t)row * D) + lane; const f32x4* yr = (const f32x4*)(y + (size_t)row * D) + lane;
        f32x4 v[4]; float s = 0.f;
#pragma unroll
        for (int j = 0; j < 4; ++j) { const f32x4 xv = xr[64 * j], yv = yr[64 * j]; v[j] = xv * ALPHA + yv * ys; s += (v[j].x + v[j].y) + (v[j].z + v[j].w); }
        const float mean = wave_sum(s) * (1.f / D); float s2 = 0.f;
#pragma unroll
        for (int j = 0; j < 4; ++j) { v[j] = v[j] - mean; s2 += (v[j].x * v[j].x + v[j].y * v[j].y) + (v[j].z * v[j].z + v[j].w * v[j].w); }
        const float rstd = 1.f / sqrtf(wave_sum(s2) * (1.f / D) + LN_EPS);
#pragma unroll
        for (int j = 0; j < 4; ++j) v[j] = v[j] * rstd * gv[j] + bv[j];
        f32x4* xo = (f32x4*)(xout + (size_t)row * D) + lane;
#pragma unroll
        for (int j = 0; j < 4; ++j) xo[64 * j] = v[j];
        if (xb) { v2u* o8 = (v2u*)(xb + (size_t)row * D) + lane;
#pragma unroll
            for (int j = 0; j < 4; ++j) { v2u o; o.x = pk2(v[j].x, v[j].y); o.y = pk2(v[j].z, v[j].w); o8[64 * j] = o; } }
        if (wif) {
            float mine = 0.f;
#pragma unroll
            for (int q = 0; q < 8; ++q) { float p = 0.f;
#pragma unroll
                for (int j = 0; j < 4; ++j) { const f32x4 w = ((const LAS f32x4*)(wl + q * D))[lane + 64 * j]; p += (v[j].x * w.x + v[j].y * w.y) + (v[j].z * w.z + v[j].w * w.w); }
                p = wave_sum(p); if (lane == q) mine = p; }
            if (lane < 8) gates[(size_t)row * 8 + lane] = mine + (lane < 4 ? b_i[lane] : b_f[lane - 4]);
        }
    }
    if (wif) __syncthreads();
}
constexpr int PAB = AB_IN;
__device__ __forceinline__ void ab_stats_phase(const bf16_t* P, float* kmean, float* stats, int gw, int ngw) {
    int lane; { int l_ = threadIdx.x; asm volatile("" : "+v"(l_)); lane = l_ & 63; }
    const int r8 = lane >> 3, c8 = lane & 7;
    for (int it = gw; it < NB * 8 * 32; it += ngw) {
        const int b = it >> 8, h = (it >> 5) & 7, blk = it & 31;
        const bf16_t* kp = P + (size_t)(b * SEQ + blk * 256 + r8) * PAB + 1024 + h * 64 + c8 * 8;
        float s[8];
#pragma unroll
        for (int e = 0; e < 8; ++e) s[e] = 0.f;
#pragma unroll 4
        for (int i = 0; i < 32; ++i) { const v4u w = *(const v4u*)(kp + (size_t)(8 * i) * PAB);
            s[0] += bflo(w.x); s[1] += bfhi(w.x); s[2] += bflo(w.y); s[3] += bfhi(w.y); s[4] += bflo(w.z); s[5] += bfhi(w.z); s[6] += bflo(w.w); s[7] += bfhi(w.w); }
#pragma unroll
        for (int e = 0; e < 8; ++e) { s[e] += __shfl_xor(s[e], 8); s[e] += __shfl_xor(s[e], 16); s[e] += __shfl_xor(s[e], 32); }
        if (r8 == 0) { float* o = kmean + (size_t)it * 64 + c8 * 8;
#pragma unroll
            for (int e = 0; e < 8; ++e) o[e] = s[e] * (1.0f / 256.0f); }
    }
    for (int row = gw; row < T; row += ngw) {
        const v4u w = *(const v4u*)(P + (size_t)row * PAB + 2048 + lane * 8);
        float v[8] = { bflo(w.x), bfhi(w.x), bflo(w.y), bfhi(w.y), bflo(w.z), bfhi(w.z), bflo(w.w), bfhi(w.w) };
        float s = 0.f;
#pragma unroll
        for (int e = 0; e < 8; ++e) s += v[e];
        const float mean = wave_sum(s) * (1.0f / 512.0f); float q = 0.f;
#pragma unroll
        for (int e = 0; e < 8; ++e) { const float d = v[e] - mean; q += d * d; }
        const float rstd = 1.0f / sqrtf(wave_sum(q) * (1.0f / 512.0f) + LN_EPS);
        if (lane == 0) { stats[2 * row] = mean; stats[2 * row + 1] = rstd; }
    }
}
__device__ __forceinline__ void ab_select_phase(const bf16_t* P, const float* kmean, unsigned* sel, int gw, int ngw) {
    int lane; { int l_ = threadIdx.x; asm volatile("" : "+v"(l_)); lane = l_ & 63; }
    for (int it = gw; it < NB * 8 * 128; it += ngw) {
        const int b = it >> 10, h = (it >> 7) & 7, qc = it & 127, qblk = qc >> 2;
        const int tok = b * SEQ + qc * 64 + lane;
        unsigned mask = 0u;
        if (qblk > 0) {
            float q[64];
            const v4u* qp = (const v4u*)(P + (size_t)tok * PAB + h * 64);
#pragma unroll
            for (int j = 0; j < 8; ++j) { const v4u w = qp[j]; q[8 * j] = bflo(w.x); q[8 * j + 1] = bfhi(w.x); q[8 * j + 2] = bflo(w.y); q[8 * j + 3] = bfhi(w.y);
                q[8 * j + 4] = bflo(w.z); q[8 * j + 5] = bfhi(w.z); q[8 * j + 6] = bflo(w.w); q[8 * j + 7] = bfhi(w.w); }
            float v0 = -INFINITY, v1 = -INFINITY, v2 = -INFINITY; int i0 = -1, i1 = -1, i2 = -1;
            const float* km = kmean + (size_t)((b * 8 + h) * 32) * 64;
            for (int n = 0; n < qblk; ++n) {
                float g = 0.f;
#pragma unroll
                for (int d = 0; d < 64; ++d) g += q[d] * km[n * 64 + d];
                if (g > v0) { v2 = v1; i2 = i1; v1 = v0; i1 = i0; v0 = g; i0 = n; }
                else if (g > v1) { v2 = v1; i2 = i1; v1 = g; i1 = n; }
                else if (g > v2) { v2 = g; i2 = n; }
            }
            if (i0 >= 0) mask |= 1u << i0;
            if (i1 >= 0) mask |= 1u << i1;
            if (i2 >= 0) mask |= 1u << i2;
        }
        sel[(size_t)tok * 8 + h] = mask;
    }
}
__device__ __forceinline__ void sgu_phase(bf16_t* P, const float* stats, const float* lng, const float* lnb, const float* sw, const float* sb, LAS unsigned char* lds, int vcu, int G) {
    int tid_ = threadIdx.x; asm volatile("" : "+v"(tid_)); const int tid = tid_, lane = tid & 63, w = __builtin_amdgcn_readfirstlane(tid >> 6);
    LAS bf16_t* A = (LAS bf16_t*)lds;
    LAS bf16_t* Bt = (LAS bf16_t*)(lds + 128 * 136 * 2);
    const int fr = lane & 15, fq = lane >> 4;
    for (int it = vcu; it < 256 * 8; it += G) {
        const int ci = it >> 3, g = it & 7; const int tok0 = ci * 128;
        { const int t = tid >> 2, s0 = (tid & 3) * 32; const f32x4* wp = (const f32x4*)(sw + (size_t)(g * 128 + t) * 128 + s0);
#pragma unroll
          for (int j = 0; j < 4; ++j) { f32x4 p = wp[2 * j], q = wp[2 * j + 1]; const int s = s0 + 8 * j;
              v4u o; o.x = pk2(s <= t ? p.x : 0.f, s + 1 <= t ? p.y : 0.f); o.y = pk2(s + 2 <= t ? p.z : 0.f, s + 3 <= t ? p.w : 0.f);
              o.z = pk2(s + 4 <= t ? q.x : 0.f, s + 5 <= t ? q.y : 0.f); o.w = pk2(s + 6 <= t ? q.z : 0.f, s + 7 <= t ? q.w : 0.f);
              *(LAS v4u*)(A + t * 136 + s) = o; } }
        { const int s = tid >> 2, d0 = (tid & 3) * 16; const int tok = tok0 + s;
          const float mean = stats[2 * tok], rstd = stats[2 * tok + 1];
          const v4u* vp = (const v4u*)(P + (size_t)tok * PAB + 2048 + g * 64 + d0);
#pragma unroll
          for (int j = 0; j < 2; ++j) { const v4u wv = vp[j]; const float v[8] = { bflo(wv.x), bfhi(wv.x), bflo(wv.y), bfhi(wv.y), bflo(wv.z), bfhi(wv.z), bflo(wv.w), bfhi(wv.w) };
#pragma unroll
              for (int e = 0; e < 8; ++e) { const int d = d0 + 8 * j + e; const float vn = (v[e] - mean) * rstd * lng[g * 64 + d] + lnb[g * 64 + d];
                  Bt[d * 136 + s] = (bf16_t)f2bf(vn); } } }
        __syncthreads();
        f32x4 acc[4];
#pragma unroll
        for (int ct = 0; ct < 4; ++ct) acc[ct] = (f32x4){0.f, 0.f, 0.f, 0.f};
#pragma unroll
        for (int kk = 0; kk < 4; ++kk) {
            if (32 * kk <= 16 * w + 15) {
                const bf16x8 a = *(const LAS bf16x8*)(A + (16 * w + fr) * 136 + 32 * kk + 8 * fq);
#pragma unroll
                for (int ct = 0; ct < 4; ++ct) { const bf16x8 bb = *(const LAS bf16x8*)(Bt + (16 * ct + fr) * 136 + 32 * kk + 8 * fq);
                    acc[ct] = __builtin_amdgcn_mfma_f32_16x16x32_bf16(a, bb, acc[ct], 0, 0, 0); }
            }
        }
#pragma unroll
        for (int r = 0; r < 4; ++r) { const int t = 16 * w + 4 * fq + r; const float bias = sb[g * 128 + t];
#pragma unroll
            for (int ct = 0; ct < 4; ++ct) { bf16_t* up = P + (size_t)(tok0 + t) * PAB + 512 + g * 64 + 16 * ct + fr;
                const float u = bf2f(*up); *up = (bf16_t)f2bf(u * (acc[ct][r] + bias)); } }
        __syncthreads();
    }
}
constexpr int PC = C_PROJ;
__device__ __forceinline__ float wave_incl_sum(float v, int lane) {
#pragma unroll
    for (int o = 1; o < 64; o <<= 1) { const float t = __shfl_up(v, o); if (lane >= o) v += t; }
    return v;
}
__device__ __forceinline__ float wave_incl_max(float v, int lane) {
#pragma unroll
    for (int o = 1; o < 64; o <<= 1) { const float t = __shfl_up(v, o); if (lane >= o) v = fmaxf(v, t); }
    return v;
}
__device__ __forceinline__ float log_sigmoid(float f) { return fminf(f, 0.f) - log1pf(expf(-fabsf(f))); }
__device__ __forceinline__ void unpack8(const v4u w, float* x) { x[0] = bflo(w.x); x[1] = bfhi(w.x); x[2] = bflo(w.y); x[3] = bfhi(w.y); x[4] = bflo(w.z); x[5] = bfhi(w.z); x[6] = bflo(w.w); x[7] = bfhi(w.w); }
template <bool TRANS> __device__ __forceinline__ void stage_conv(LAS bf16_t* dst, int ld, const bf16_t* P, int tok0, int cseq, int colbase, const float* cw, const float* cb, float scale, int tid) {
    const int t = tid >> 3, cg = tid & 7; const int col = colbase + 16 * cg;
    float acc[16];
#pragma unroll
    for (int e = 0; e < 16; ++e) acc[e] = cb[col + e];
#pragma unroll
    for (int i = 0; i < 4; ++i) { const int tt = t - 3 + i;
        if (cseq > 0 || tt >= 0) { const v4u* xp = (const v4u*)(P + (size_t)(tok0 + tt) * PC + col); float x[16]; unpack8(xp[0], x); unpack8(xp[1], x + 8);
#pragma unroll
            for (int e = 0; e < 16; ++e) acc[e] += cw[i * 1024 + col + e] * x[e]; } }
#pragma unroll
    for (int e = 0; e < 16; ++e) { const float y = acc[e]; acc[e] = y * pg8::fast_sigmoid(y) * scale; }
    if (TRANS) {
#pragma unroll
        for (int e = 0; e < 16; ++e) dst[(16 * cg + e) * ld + t] = (bf16_t)f2bf(acc[e]);
    } else {
        v4u o0, o1; o0.x = pk2(acc[0], acc[1]); o0.y = pk2(acc[2], acc[3]); o0.z = pk2(acc[4], acc[5]); o0.w = pk2(acc[6], acc[7]);
        o1.x = pk2(acc[8], acc[9]); o1.y = pk2(acc[10], acc[11]); o1.z = pk2(acc[12], acc[13]); o1.w = pk2(acc[14], acc[15]);
        *(LAS v4u*)(dst + t * ld + 16 * cg) = o0; *(LAS v4u*)(dst + t * ld + 16 * cg + 8) = o1;
    }
}
__device__ __forceinline__ void stage_vt(LAS bf16_t* Vt, const bf16_t* P, int tok0, int colbase, const LAS float* wl, int tid) {
    const int s = tid >> 3, g = tid & 7; const v4u* vp = (const v4u*)(P + (size_t)(tok0 + s) * PC + colbase + 32 * g);
    const float w = wl ? wl[s] : 1.0f;
#pragma unroll
    for (int j = 0; j < 4; ++j) { float x[8]; unpack8(vp[j], x);
#pragma unroll
        for (int e = 0; e < 8; ++e) Vt[(32 * g + 8 * j + e) * 72 + s] = (bf16_t)f2bf(x[e] * w); }
}
__device__ __forceinline__ void mlstm_kv_phase(const bf16_t* P, const float* gates, const float* cw, const float* cb, bf16_t* state, float* bend, float* amax, float* ks,
                                               LAS unsigned char* lds, int vcu, int G) {
    const int w = __builtin_amdgcn_readfirstlane(threadIdx.x >> 6);
    LAS bf16_t* Kt = (LAS bf16_t*)lds;
    LAS bf16_t* Vt = (LAS bf16_t*)(lds + 18432);
    LAS float* wl = (LAS float*)(lds + 18432 + 36864);
    for (int it = vcu; it < 16 * 128; it += G) {
        int tid_ = threadIdx.x; asm volatile("" : "+v"(tid_)); const int tid = tid_, lane = tid & 63, fr = lane & 15, fq = lane >> 4;
        const int bh = it >> 7, c = it & 127, b = bh >> 2, h = bh & 3; const int tok0 = b * SEQ + c * 64;
        if (w == 0) {
            const float ig = gates[(size_t)(tok0 + lane) * 8 + h], fg = gates[(size_t)(tok0 + lane) * 8 + 4 + h];
            const float bb = wave_incl_sum(log_sigmoid(fg), lane);
            const float be = __shfl(bb, 63);
            const float a = be - bb + ig; const float am = wave_max(a);
            wl[lane] = expf(a - am);
            if (lane == 0) { bend[it] = be; amax[it] = am; }
        }
        stage_conv<true>(Kt, 72, P, tok0, c, 512 + h * 128, cw, cb, 0.08838834764831845f, tid);
        __syncthreads();
        stage_vt(Vt, P, tok0, 1024 + h * 256, wl, tid);
        if (tid < 128) { float s = 0.f;
#pragma unroll 8
            for (int j = 0; j < 64; ++j) s += bf2f(Kt[tid * 72 + j]) * wl[j];
            ks[(size_t)it * 128 + tid] = s; }
        __syncthreads();
        f32x4 acc[8][2];
#pragma unroll
        for (int mt = 0; mt < 8; ++mt) { acc[mt][0] = (f32x4){0.f, 0.f, 0.f, 0.f}; acc[mt][1] = (f32x4){0.f, 0.f, 0.f, 0.f}; }
#pragma unroll
        for (int kk = 0; kk < 2; ++kk) {
            const bf16x8 b0 = *(const LAS bf16x8*)(Vt + (32 * w + fr) * 72 + 32 * kk + 8 * fq), b1 = *(const LAS bf16x8*)(Vt + (32 * w + 16 + fr) * 72 + 32 * kk + 8 * fq);
#pragma unroll
            for (int mt = 0; mt < 8; ++mt) { const bf16x8 a = *(const LAS bf16x8*)(Kt + (16 * mt + fr) * 72 + 32 * kk + 8 * fq);
                acc[mt][0] = __builtin_amdgcn_mfma_f32_16x16x32_bf16(a, b0, acc[mt][0], 0, 0, 0); acc[mt][1] = __builtin_amdgcn_mfma_f32_16x16x32_bf16(a, b1, acc[mt][1], 0, 0, 0); }
        }
        bf16_t* st = state + (size_t)it * 32768;
#pragma unroll
        for (int mt = 0; mt < 8; ++mt)
#pragma unroll
            for (int nt = 0; nt < 2; ++nt) { const f32x4 v = acc[mt][nt]; v2u o; o.x = pk2(v[0], v[1]); o.y = pk2(v[2], v[3]);
                *(v2u*)(st + (size_t)(32 * w + 16 * nt + fr) * 128 + 16 * mt + 4 * fq) = o; }
        __syncthreads();
    }
}
__device__ __forceinline__ void mlstm_scan_phase(bf16_t* state, const float* bend, const float* amax, const float* ks, float* nin, float* min_) {
    int tid_ = threadIdx.x; asm volatile("" : "+v"(tid_)); const int tid = tid_;
    const int bx = blockIdx.x; const int bh = bx >> 4; const bool nscan = ((bx & 15) == 0) && tid < 128;
    bf16_t* sp = state + (size_t)bh * 128 * 32768 + (size_t)((bx & 15) * 512 + tid) * 4;
    float C0 = 0.f, C1 = 0.f, C2 = 0.f, C3 = 0.f, n = 0.f, m = 0.f;
    for (int c0 = 0; c0 < 128; c0 += 8) {
        v2u kv[8];
#pragma unroll
        for (int j = 0; j < 8; ++j) kv[j] = *(const v2u*)(sp + (size_t)(c0 + j) * 32768);
#pragma unroll
        for (int j = 0; j < 8; ++j) { const int c = c0 + j;
            const float be = bend[bh * 128 + c], am = amax[bh * 128 + c];
            const float mn = fmaxf(be + m, am); const float dec = expf(be + m - mn), inj = expf(am - mn);
            v2u o; o.x = pk2(C0, C1); o.y = pk2(C2, C3); *(v2u*)(sp + (size_t)c * 32768) = o;
            C0 = dec * C0 + inj * bflo(kv[j].x); C1 = dec * C1 + inj * bfhi(kv[j].x); C2 = dec * C2 + inj * bflo(kv[j].y); C3 = dec * C3 + inj * bfhi(kv[j].y);
            if (nscan) { nin[(size_t)(bh * 128 + c) * 128 + tid] = n; n = dec * n + inj * ks[(size_t)(bh * 128 + c) * 128 + tid]; if (tid == 0) min_[bh * 128 + c] = m; }
            m = mn; }
    }
}
__device__ __forceinline__ void mlstm_out_phase(const bf16_t* P, const float* gates, const float* cw, const float* cb, const bf16_t* state, const float* nin, const float* min_,
                                                const float* headg, bf16_t* mix, LAS unsigned char* lds, int vcu, int G) {
    const int w = __builtin_amdgcn_readfirstlane(threadIdx.x >> 6);
    LAS bf16_t* Qs = (LAS bf16_t*)lds;
    LAS bf16_t* Ks = (LAS bf16_t*)(lds + 17408);
    LAS bf16_t* Vt = (LAS bf16_t*)(lds + 34816);
    LAS bf16_t* Ps = (LAS bf16_t*)(lds + 71680);
    LAS float* fl = (LAS float*)(lds + 80896);
    LAS float* bv = fl, *ibv = fl + 64, *mtv = fl + 128, *itv = fl + 192, *dp0 = fl + 256, *dp1 = fl + 320, *d2v = fl + 384, *unused_ = fl + 448; (void)unused_;
    LAS float* Hs = (LAS float*)lds;
    for (int it = vcu; it < 16 * 128; it += G) {
        int tid_ = threadIdx.x; asm volatile("" : "+v"(tid_)); const int tid = tid_, lane = tid & 63, fr = lane & 15, fq = lane >> 4;
        const int bh = it >> 7, c = it & 127, b = bh >> 2, h = bh & 3; const int tok0 = b * SEQ + c * 64;
        if (w == 0) {
            const float ig = gates[(size_t)(tok0 + lane) * 8 + h], fg = gates[(size_t)(tok0 + lane) * 8 + 4 + h];
            const float bb = wave_incl_sum(log_sigmoid(fg), lane);
            const float ib = ig - bb; const float cm = wave_incl_max(ib, lane);
            const float mi = min_[it]; const float mt = bb + fmaxf(mi, cm);
            bv[lane] = bb; ibv[lane] = ib; mtv[lane] = mt; itv[lane] = expf(bb + mi - mt);
        }
        stage_conv<false>(Qs, 136, P, tok0, c, h * 128, cw, cb, 1.0f, tid);
        stage_conv<false>(Ks, 136, P, tok0, c, 512 + h * 128, cw, cb, 0.08838834764831845f, tid);
        stage_vt(Vt, P, tok0, 1024 + h * 256, nullptr, tid);
        __syncthreads();
        {
            const int rt = w >> 1, ch = w & 1;
            f32x4 sa[2] = { (f32x4){0.f, 0.f, 0.f, 0.f}, (f32x4){0.f, 0.f, 0.f, 0.f} };
#pragma unroll
            for (int kk = 0; kk < 4; ++kk) { const bf16x8 a = *(const LAS bf16x8*)(Qs + (16 * rt + fr) * 136 + 32 * kk + 8 * fq);
#pragma unroll
                for (int j = 0; j < 2; ++j) { const bf16x8 bb = *(const LAS bf16x8*)(Ks + (16 * (2 * ch + j) + fr) * 136 + 32 * kk + 8 * fq);
                    sa[j] = __builtin_amdgcn_mfma_f32_16x16x32_bf16(a, bb, sa[j], 0, 0, 0); } }
#pragma unroll
            for (int r = 0; r < 4; ++r) { const int t = 16 * rt + 4 * fq + r; const float bt = bv[t] - mtv[t]; float rs = 0.f;
#pragma unroll
                for (int j = 0; j < 2; ++j) { const int s = 16 * (2 * ch + j) + fr; const float p = (s <= t) ? sa[j][r] * expf(bt + ibv[s]) : 0.f; rs += p; Ps[t * 72 + s] = (bf16_t)f2bf(p); }
                rs += __shfl_xor(rs, 1); rs += __shfl_xor(rs, 2); rs += __shfl_xor(rs, 4); rs += __shfl_xor(rs, 8);
                if (fr == 0) { if (ch == 0) dp0[t] = rs; else dp1[t] = rs; } }
        }
        if (w == 7) { float s = 0.f; const float* np = nin + (size_t)it * 128;
#pragma unroll 8
            for (int k = 0; k < 128; ++k) s += bf2f(Qs[lane * 136 + k]) * np[k];
            d2v[lane] = s; }
        __syncthreads();
        f32x4 a1[4][2], a2[4][2];
#pragma unroll
        for (int rt = 0; rt < 4; ++rt)
#pragma unroll
            for (int ct = 0; ct < 2; ++ct) { a1[rt][ct] = (f32x4){0.f, 0.f, 0.f, 0.f}; a2[rt][ct] = (f32x4){0.f, 0.f, 0.f, 0.f}; }
#pragma unroll
        for (int kk = 0; kk < 2; ++kk) {
            const bf16x8 b0 = *(const LAS bf16x8*)(Vt + (32 * w + fr) * 72 + 32 * kk + 8 * fq), b1 = *(const LAS bf16x8*)(Vt + (32 * w + 16 + fr) * 72 + 32 * kk + 8 * fq);
#pragma unroll
            for (int rt = 0; rt < 4; ++rt) { const bf16x8 a = *(const LAS bf16x8*)(Ps + (16 * rt + fr) * 72 + 32 * kk + 8 * fq);
                a1[rt][0] = __builtin_amdgcn_mfma_f32_16x16x32_bf16(a, b0, a1[rt][0], 0, 0, 0); a1[rt][1] = __builtin_amdgcn_mfma_f32_16x16x32_bf16(a, b1, a1[rt][1], 0, 0, 0); }
        }
        const bf16_t* st = state + (size_t)it * 32768;
#pragma unroll
        for (int kk = 0; kk < 4; ++kk) {
            const bf16x8 b0 = *(const bf16x8*)(st + (size_t)(32 * w + fr) * 128 + 32 * kk + 8 * fq), b1 = *(const bf16x8*)(st + (size_t)(32 * w + 16 + fr) * 128 + 32 * kk + 8 * fq);
#pragma unroll
            for (int rt = 0; rt < 4; ++rt) { const bf16x8 a = *(const LAS bf16x8*)(Qs + (16 * rt + fr) * 136 + 32 * kk + 8 * fq);
                a2[rt][0] = __builtin_amdgcn_mfma_f32_16x16x32_bf16(a, b0, a2[rt][0], 0, 0, 0); a2[rt][1] = __builtin_amdgcn_mfma_f32_16x16x32_bf16(a, b1, a2[rt][1], 0, 0, 0); }
        }
        __syncthreads();
#pragma unroll
        for (int rt = 0; rt < 4; ++rt)
#pragma unroll
            for (int r = 0; r < 4; ++r) { const int t = 16 * rt + 4 * fq + r; const float inter = itv[t];
                const float den = dp0[t] + dp1[t] + inter * d2v[t]; const float rd = 1.0f / fmaxf(fabsf(den), expf(-mtv[t]));
                Hs[t * 260 + 32 * w + fr] = (a1[rt][0][r] + inter * a2[rt][0][r]) * rd;
                Hs[t * 260 + 32 * w + 16 + fr] = (a1[rt][1][r] + inter * a2[rt][1][r]) * rd; }
        __syncthreads();
        { const f32x4 hg = *(const f32x4*)(headg + h * 256 + 4 * lane);
#pragma unroll
          for (int i = 0; i < 8; ++i) { const int t = 8 * w + i; const f32x4 v = *(const LAS f32x4*)(Hs + t * 260 + 4 * lane);
              const float mu = wave_sum((v.x + v.y) + (v.z + v.w)) * (1.0f / 256.0f);
              const f32x4 d = v - mu; const float var = wave_sum((d.x * d.x + d.y * d.y) + (d.z * d.z + d.w * d.w)) * (1.0f / 256.0f);
              const float rstd = 1.0f / sqrtf(var + LN_EPS); const size_t tok = (size_t)(tok0 + t);
              const v2u ow = *(const v2u*)(P + tok * PC + 2048 + h * 256 + 4 * lane);
              v2u o; o.x = pk2(d.x * rstd * hg.x * pg8::fast_sigmoid(bflo(ow.x)), d.y * rstd * hg.y * pg8::fast_sigmoid(bfhi(ow.x)));
              o.y = pk2(d.z * rstd * hg.z * pg8::fast_sigmoid(bflo(ow.y)), d.w * rstd * hg.w * pg8::fast_sigmoid(bfhi(ow.y)));
              *(v2u*)(mix + tok * D + h * 256 + 4 * lane) = o; } }
        __syncthreads();
    }
}
#define MIXER_AB \
    PHASE({ pg8::Gemm g{XB, (const bf16_t*)(ws + WS_WABI), T, AB_IN, D, D}; pg8::StaticOrder S; S.init(T, AB_IN, G, bx); \
            pg8::EpiAB E{BIG, AB_IN, (const float*)(ws + WS_ROPE), (const float*)(ws + WS_ROPE) + SEQ * 32, attn_body::C2}; \
            pg8::gemm_phase<pg8::EpiAB, pg8::StaticOrder, true, true>(lds, g, S, E); }); \
    PHASE(ab_stats_phase(BIG, (float*)(ws + WS_KMEAN), (float*)(ws + WS_STATS), gw, ngw)); \
    PHASE(ab_select_phase(BIG, (const float*)(ws + WS_KMEAN), (unsigned*)(ws + WS_SEL), gw, ngw)); \
    PHASE({ const attn_body::AttnTensors AT{(const attn_body::bf16*)BIG, (const attn_body::bf16*)(BIG + 1024), (const attn_body::bf16*)(BIG + 1536), (attn_body::bf16*)BIG, (const unsigned*)(ws + WS_SEL)}; \
            const attn_body::StaticOrder S(G, bx); attn_body::attn_phase<attn_body::StaticOrder>((char*)lds_raw, AT, S); \
            sgu_phase(BIG, (const float*)(ws + WS_STATS), IN(6), IN(7), IN(8), IN(9), lds, vcu, G); }); \
    PHASE({ pg8::Gemm g{BIG, (const bf16_t*)(ws + WS_WABO), T, D, D, AB_IN}; pg8::StaticOrder S; S.init(T, D, G, bx); \
            pg8::EpiF32 E{Y, D}; pg8::gemm_phase<pg8::EpiF32, pg8::StaticOrder, true, true>(lds, g, S, E); });
#define MIXER_C \
    PHASE({ pg8::Gemm g{XB, (const bf16_t*)(ws + WS_WCI), T, C_PROJ, D, D}; pg8::StaticOrder S; S.init(T, C_PROJ, G, bx); \
            pg8::EpiBf16Plain E{BIG, C_PROJ}; pg8::gemm_phase<pg8::EpiBf16Plain, pg8::StaticOrder, true, true>(lds, g, S, E); }); \
    PHASE(mlstm_kv_phase(BIG, (const float*)(ws + WS_GATES), IN(12), IN(13), (bf16_t*)Y, (float*)(ws + WS_BEND), (float*)(ws + WS_AMAX), (float*)(ws + WS_KS), lds, vcu, G)); \
    PHASE(mlstm_scan_phase((bf16_t*)Y, (const float*)(ws + WS_BEND), (const float*)(ws + WS_AMAX), (const float*)(ws + WS_KS), (float*)(ws + WS_NIN), (float*)(ws + WS_MIN))); \
    PHASE(mlstm_out_phase(BIG, (const float*)(ws + WS_GATES), IN(12), IN(13), (const bf16_t*)Y, (const float*)(ws + WS_NIN), (const float*)(ws + WS_MIN), IN(16), XB, lds, vcu, G)); \
    PHASE({ pg8::Gemm g{XB, (const bf16_t*)(ws + WS_WCO), T, D, D, D}; pg8::StaticOrder S; S.init(T, D, G, bx); \
            pg8::EpiF32 E{Y, D}; pg8::gemm_phase<pg8::EpiF32, pg8::StaticOrder, true, true>(lds, g, S, E); });
#define MIXER_C_YS 1.0f
__global__ void __launch_bounds__(NWAVES * 64, 2) mk_fwd(Args args) {
    extern __shared__ __attribute__((aligned(16))) unsigned char lds_raw[];
    LAS unsigned char* lds = (LAS unsigned char*)lds_raw;
    { cg::grid_group grid = cg::this_grid(); if (args.ph_hi - args.ph_lo > 1) grid.sync(); }
    if (threadIdx.x < 8) ((LAS unsigned*)(lds + LDS_MISC))[threadIdx.x] = 0u;
    __syncthreads();
    XcdBarrier bar = xcd_barrier_post((unsigned*)(GASP unsigned*)(unsigned long long)args.ws, (volatile LAS unsigned*)(lds + LDS_MISC));
    const int wave = __builtin_amdgcn_readfirstlane(threadIdx.x >> 6);
    const int G = gridDim.x, bx = blockIdx.x;
    const int vcu = (G % 8 == 0) ? (bx % 8) * (G / 8) + bx / 8 : bx;
    const int gw = vcu * NWAVES + wave, ngw = G * NWAVES;
    const int lo = args.ph_lo, hi = args.ph_hi; int ph = 0;
#define PHASE(...) do { if (ph >= lo && ph < hi) { KP kp = (KP)__builtin_amdgcn_kernarg_segment_ptr(); asm volatile("" : "+s"(kp)); \
        unsigned char* ws = (unsigned char*)(GASP unsigned char*)kp[19]; bf16_t* XB = (bf16_t*)(ws + WS_XB); bf16_t* BIG = (bf16_t*)(ws + WS_BIG); float* Y = (float*)(ws + WS_Y); float* XF = (float*)(GASP float*)kp[18]; \
        const float* lng = (const float*)(GASP const float*)kp[1]; const float* lnb = (const float*)(GASP const float*)kp[2]; (void)XB; (void)BIG; (void)Y; (void)XF; (void)lng; (void)lnb; \
        __VA_ARGS__; if (ph + 1 < hi) xcd_barrier(bar); } ++ph; } while (0)
#define IN(i) ((const float*)(GASP const float*)kp[i])

    PHASE(prologue(kp, lds, gw, ngw, wave));

#define LN_MIX(l, ys) PHASE(ln_phase(XF, Y, ys, lng + ((l) * 3 + 1) * D, lnb + ((l) * 3 + 1) * D, XF, XB, nullptr, nullptr, nullptr, nullptr, lds, gw, ngw))
#define FFN_HALF(l, half) do { const int wi = (l) * 2 + (half); \
            PHASE({ pg8::Gemm g{XB, (const bf16_t*)(ws + WS_WGU) + (size_t)wi * 2 * FF * D, T, 2 * FF, D, D}; pg8::StaticOrder S; S.init(T, 2 * FF, G, bx); \
                    pg8::EpiSwiGLU E{BIG, FF}; pg8::gemm_phase<pg8::EpiSwiGLU, pg8::StaticOrder, true, true>(lds, g, S, E); }); \
            PHASE({ pg8::Gemm g{BIG, (const bf16_t*)(ws + WS_WD) + (size_t)wi * D * FF, T, D, FF, FF}; pg8::StaticOrder S; S.init(T, D, G, bx); \
                    pg8::EpiF32 E{Y, D}; pg8::gemm_phase<pg8::EpiF32, pg8::StaticOrder, true, true>(lds, g, S, E); }); \
            const int li = (l) * 3 + ((half) == 0 ? 0 : 2); \
            const bool first = ((l) == 0 && (half) == 0), gates = ((l) == 1 && (half) == 0), last = ((l) == 1 && (half) == 1); \
            PHASE(ln_phase(first ? IN(0) : XF, Y, 0.5f, lng + li * D, lnb + li * D, XF, last ? nullptr : XB, \
                           gates ? (const float*)(ws + WS_WIF) : nullptr, (float*)(ws + WS_GATES), IN(14), IN(15), lds, gw, ngw)); } while (0)
    FFN_HALF(0, 0);
    MIXER_AB
    LN_MIX(0, 1.0f);
    FFN_HALF(0, 1);
    FFN_HALF(1, 0);
    MIXER_C
    LN_MIX(1, MIXER_C_YS);
    FFN_HALF(1, 1);
#undef PHASE
}

extern "C" void kernel_launch(void* const* d_in, const int* in_sizes, int n_in, void* d_out, int out_size, void* d_ws, size_t ws_size, hipStream_t stream) {
    static int grid = 0;
    if (grid == 0) {
        if (n_in != 18 || in_sizes[0] != T * D || out_size != T * D || ws_size < WS_END) { fprintf(stderr, "kernel_launch: unexpected shapes (n_in %d, in0 %d, out %d, ws %zu)\n", n_in, n_in > 0 ? in_sizes[0] : -1, out_size, ws_size); grid = -1; return; }
        int dev = 0, cus = 0, per_cu = 0;
        (void)hipGetDevice(&dev); (void)hipDeviceGetAttribute(&cus, hipDeviceAttributeMultiprocessorCount, dev);
        if (hipFuncSetAttribute((const void*)mk_fwd, hipFuncAttributeMaxDynamicSharedMemorySize, LDS_BYTES) != hipSuccess) { fprintf(stderr, "kernel_launch: hipFuncSetAttribute failed\n"); grid = -1; return; }
        (void)hipOccupancyMaxActiveBlocksPerMultiprocessor(&per_cu, (const void*)mk_fwd, NWAVES * 64, LDS_BYTES);
        (void)hipGetLastError();
        if (per_cu < 1) per_cu = 1;
        grid = cus;
        fprintf(stderr, "kernel_launch: cus %d per_cu %d grid %d\n", cus, per_cu, grid);
    }
    if (grid < 0) return;
    if (hipMemsetAsync(d_ws, 0, 65536, stream) != hipSuccess) { fprintf(stderr, "kernel_launch: memset failed\n"); return; }
    Args a{};
    for (int i = 0; i < 18; ++i) a.in[i] = (const float*)d_in[i];
    a.out = (float*)d_out; a.ws = (unsigned char*)d_ws;
#if MK_MULTI
    for (int p = 0; p < MK_NPHASES; ++p) { a.ph_lo = p; a.ph_hi = p + 1; hipLaunchKernelGGL(mk_fwd, dim3(grid), dim3(NWAVES * 64), LDS_BYTES, stream, a); }
#else
    a.ph_lo = 0; a.ph_hi = 1 << 20;
    void* kargs[] = { &a };
    hipError_t e = hipLaunchCooperativeKernel((const void*)mk_fwd, dim3(grid), dim3(NWAVES * 64), kargs, LDS_BYTES, stream);
    if (e != hipSuccess) fprintf(stderr, "kernel_launch: cooperative launch failed: %s (grid %d)\n", hipGetErrorString(e), grid);
#endif
}
```
